# Optimizing an MI355X kernel written in HIP

```python
import jax, jax.numpy as jnp
from jax import lax
import numpy as np

D_MODEL = 1024
BATCH = 16
SEQ = 2048
DEPTH = 1

CTX_LEN = 256
GRID_W = 64
D_MIX = 1024
HEAD_DIM = 64
N_Q_HEADS = 8
N_KV_HEADS = 2
Q_PER_KV = N_Q_HEADS // N_KV_HEADS
D_ATTN = N_Q_HEADS * HEAD_DIM
D_KV = N_KV_HEADS * HEAD_DIM
N_GM_GROUPS = 8
GM_GROUP_DIM = 64
D_GM = N_GM_GROUPS * GM_GROUP_DIM
CHUNK = 128
Q_BLOCK = 128
D_IN = D_ATTN + 2 * D_KV + 2 * D_GM
ROPE_THETA = 10000.0
N_EXPERTS = 16
CAPACITY_FACTOR = 2
EXPERT_FF = 2048
EPS = 1e-6

kernel_name = "hybrid_gqa_gmlp_ecmoe_dit_layer"


def rmsnorm(x, g):
    xf = x.astype(jnp.float32)
    y = xf * lax.rsqrt(jnp.mean(xf * xf, axis=-1, keepdims=True) + EPS)
    return (y * g.astype(jnp.float32)).astype(x.dtype)


def adaln(cvec, w_mod, b_mod):
    m = jax.nn.silu(cvec) @ w_mod + b_mod
    return jnp.split(m, 6, axis=-1)


def axial_rope(row, col):
    n_freq = HEAD_DIM // 4
    inv = ROPE_THETA ** (-jnp.arange(n_freq, dtype=jnp.float32) / n_freq)
    ang = jnp.concatenate([row[:, None].astype(jnp.float32) * inv,
                           col[:, None].astype(jnp.float32) * inv], axis=-1)
    return jnp.cos(ang), jnp.sin(ang)


def apply_rope(x, cos, sin):
    shape = (cos.shape[0],) + (1,) * (x.ndim - 3) + (cos.shape[-1],)
    cos = cos.reshape(shape).astype(x.dtype)
    sin = sin.reshape(shape).astype(x.dtype)
    x1, x2 = jnp.split(x, 2, axis=-1)
    return jnp.concatenate([x1 * cos - x2 * sin, x1 * sin + x2 * cos], axis=-1)


def modulate(x, g, shift, scale):
    return rmsnorm(x, g) * (1 + scale) + shift


def split_in_proj(w_in):
    return jnp.split(w_in, [D_ATTN, D_ATTN + 2 * D_KV], axis=1)


def queries(h, w_q, q_gain):
    b, n = h.shape[:2]
    return rmsnorm((h @ w_q).reshape(b, n, N_KV_HEADS, Q_PER_KV, HEAD_DIM), q_gain)


def keys_values(h, w_kv, k_gain):
    b, n = h.shape[:2]
    k, v = jnp.split(h @ w_kv, 2, axis=-1)
    k = rmsnorm(k.reshape(b, n, N_KV_HEADS, HEAD_DIM), k_gain)
    return k, v.reshape(b, n, N_KV_HEADS, HEAD_DIM)


def gqa_attend(q, k, v):
    b, nq = q.shape[:2]
    scale = HEAD_DIM ** -0.5

    def block(qb):
        s = jnp.einsum('bqkgd,bskd->bkgqs', qb, k).astype(jnp.float32) * scale
        p = jax.nn.softmax(s, axis=-1).astype(v.dtype)
        return jnp.einsum('bkgqs,bskd->bqkgd', p, v)

    nb = nq // Q_BLOCK
    qb = jnp.moveaxis(q.reshape(b, nb, Q_BLOCK, N_KV_HEADS, Q_PER_KV, HEAD_DIM), 1, 0)
    o = lax.map(block, qb)
    return jnp.moveaxis(o, 0, 1).reshape(b, nq, D_ATTN)


def spatial_gating(h, w_gm, v_gain, w_s, b_s):
    b, n = h.shape[:2]
    u, vv = jnp.split(jax.nn.gelu(h @ w_gm, approximate=False), 2, axis=-1)
    vv = rmsnorm(vv, v_gain).reshape(b, n // CHUNK, CHUNK, N_GM_GROUPS, GM_GROUP_DIM)
    mixed = jnp.einsum('gij,bcjgd->bcigd', w_s, vv) + b_s.T[:, :, None]
    return u * mixed.reshape(b, n, D_GM)


def expert_choice_ffn(h, w_router, w1, w3, w2):
    n, d = h.shape[1], h.shape[2]
    cap = CAPACITY_FACTOR * n // N_EXPERTS
    aff = jax.nn.softmax((h @ w_router).astype(jnp.float32), axis=-1)
    gate, idx = lax.top_k(jnp.swapaxes(aff, 1, 2), cap)
    xe = jax.vmap(lambda hb, ib: hb[ib])(h, idx)
    hid = jax.nn.silu(jnp.einsum('becd,edf->becf', xe, w1)) * jnp.einsum('becd,edf->becf', xe, w3)
    ye = jnp.einsum('becf,efd->becd', hid, w2) * gate[..., None].astype(h.dtype)

    def scatter(yb, ib):
        return jnp.zeros((n, d), h.dtype).at[ib.reshape(-1)].add(yb.reshape(-1, d))

    return jax.vmap(scatter)(ye, idx)


def hybrid_layer(xl, xc, c, c_ctx, cos, sin, w_mod, b_mod, g_mix, g_ffn, w_in, q_gain, k_gain,
                 v_gain, w_s, b_s, w_out, w_router, w1, w3, w2, update_ctx):
    sh1, sc1, gt1, sh2, sc2, gt2 = [m[:, None, :] for m in adaln(c, w_mod, b_mod)]
    csh1, csc1, cgt1, csh2, csc2, cgt2 = adaln(c_ctx, w_mod, b_mod)
    w_q, w_kv, w_gm = split_in_proj(w_in)

    hl = modulate(xl, g_mix, sh1, sc1)
    hc = modulate(xc, g_mix, csh1, csc1)
    kc, vc = keys_values(hc, w_kv, k_gain)
    ql = apply_rope(queries(hl, w_q, q_gain), cos, sin)
    kl, vl = keys_values(hl, w_kv, k_gain)
    kl = apply_rope(kl, cos, sin)
    k_all = jnp.concatenate([kl, kc], axis=1)
    v_all = jnp.concatenate([vl, vc], axis=1)
    mix_l = jnp.concatenate([gqa_attend(ql, k_all, v_all),
                             spatial_gating(hl, w_gm, v_gain, w_s, b_s)], axis=-1)
    xl_new = xl + gt1 * (mix_l @ w_out)

    xl_new = xl_new + gt2 * expert_choice_ffn(modulate(xl_new, g_ffn, sh2, sc2), w_router, w1, w3, w2)

    if update_ctx:
        qc = queries(hc, w_q, q_gain)
        mix_c = jnp.concatenate([gqa_attend(qc, kc, vc),
                                 spatial_gating(hc, w_gm, v_gain, w_s, b_s)], axis=-1)
        xc = xc + cgt1 * (mix_c @ w_out)
        xc = xc + cgt2 * expert_choice_ffn(modulate(xc, g_ffn, csh2, csc2), w_router, w1, w3, w2)
    return xl_new, xc


def setup_inputs(seed: int = 0) -> dict:
    key = jax.random.key(seed)
    ks = jax.random.split(key, 21)
    f32 = jnp.float32
    L = DEPTH

    def nrm(k, shape, s):
        return jax.random.normal(k, shape, f32) * s

    return {
        "x": nrm(ks[0], (BATCH, SEQ, D_MODEL), 1.0),
        "c": nrm(ks[1], (BATCH, D_MODEL), 1.0),
        "ctx": nrm(ks[2], (BATCH, CTX_LEN, D_MODEL), 1.0),
        "c_ctx": nrm(ks[3], (D_MODEL,), 1.0),
        "w_mod": nrm(ks[4], (L, D_MODEL, 6 * D_MODEL), D_MODEL ** -0.5),
        "b_mod": nrm(ks[5], (L, 6 * D_MODEL), 0.02),
        "g_mix": 1.0 + nrm(ks[6], (L, D_MODEL), 0.02),
        "g_ffn": 1.0 + nrm(ks[7], (L, D_MODEL), 0.02),
        "w_in": nrm(ks[8], (L, D_MODEL, D_IN), D_MODEL ** -0.5),
        "q_gain": 1.0 + nrm(ks[9], (L, HEAD_DIM), 0.02),
        "k_gain": 1.0 + nrm(ks[10], (L, HEAD_DIM), 0.02),
        "v_gain": 1.0 + nrm(ks[11], (L, D_GM), 0.02),
        "w_s": nrm(ks[12], (L, N_GM_GROUPS, CHUNK, CHUNK), CHUNK ** -0.5),
        "b_s": 1.0 + nrm(ks[13], (L, N_GM_GROUPS, CHUNK), 0.02),
        "w_out": nrm(ks[14], (L, D_MIX, D_MODEL), D_MIX ** -0.5),
        "w_router": nrm(ks[15], (L, D_MODEL, N_EXPERTS), D_MODEL ** -0.5),
        "w1": nrm(ks[16], (L, N_EXPERTS, D_MODEL, EXPERT_FF), D_MODEL ** -0.5),
        "w3": nrm(ks[17], (L, N_EXPERTS, D_MODEL, EXPERT_FF), D_MODEL ** -0.5),
        "w2": nrm(ks[18], (L, N_EXPERTS, EXPERT_FF, D_MODEL), EXPERT_FF ** -0.5),
        "g_final": 1.0 + nrm(ks[19], (D_MODEL,), 0.02),
    }


def reference(x, c, ctx, c_ctx, w_mod, b_mod, g_mix, g_ffn, w_in, q_gain, k_gain, v_gain,
              w_s, b_s, w_out, w_router, w1, w3, w2, g_final):
    n_lat = x.shape[1]
    rows = n_lat // GRID_W
    row = jnp.repeat(jnp.arange(rows), GRID_W)
    col = jnp.tile(jnp.arange(GRID_W), rows)
    cos, sin = axial_rope(row, col)
    xl, xc = x, ctx
    for layer in range(DEPTH):
        xl, xc = hybrid_layer(xl, xc, c, c_ctx, cos, sin, w_mod[layer], b_mod[layer], g_mix[layer],
                              g_ffn[layer], w_in[layer], q_gain[layer], k_gain[layer], v_gain[layer],
                              w_s[layer], b_s[layer], w_out[layer], w_router[layer], w1[layer],
                              w3[layer], w2[layer], update_ctx=layer + 1 < DEPTH)
    return rmsnorm(xl, g_final)
```

```cpp
#include <hip/hip_runtime.h>
#include <stdint.h>

typedef unsigned short bf16_t;
__device__ __forceinline__ float bf2f(bf16_t v) { return __uint_as_float(((unsigned)v) << 16); }
__device__ __forceinline__ bf16_t f2bf(float f) { unsigned u = __float_as_uint(f); return (bf16_t)((u + 0x7fffu + ((u >> 16) & 1u)) >> 16); }

constexpr int NB = 16, SEQ = 2048, DM = 1024, CTXL = 256, NKEY = SEQ + CTXL;
constexpr int HD = 64, NQH = 8, NKVH = 2, DATT = 512, DKV = 128, DGM = 512, CHUNK = 128, NGRP = 8;
constexpr int DIN = 1792, NE = 16, CAP = 256, FF = 2048;
constexpr int MLAT = NB * SEQ;
constexpr int MCTX = NB * CTXL;
constexpr int MALL = MLAT + MCTX;
constexpr int NSLOT = NB * NE * CAP;
constexpr float EPS = 1e-6f;
constexpr float QSCALE = 0.125f * 1.4426950408889634f;

constexpr size_t MiB = 1u << 20;
constexpr size_t WS_MOD = 1 * MiB;
constexpr size_t WS_ROPE = 2 * MiB;
constexpr size_t WS_AFF = 3 * MiB;
constexpr size_t WS_IDX = 5 * MiB;
constexpr size_t WS_GATE = 6 * MiB;
constexpr size_t WS_INV = 7 * MiB;
constexpr size_t WS_WBF = 10 * MiB;
constexpr size_t WS_H2 = 210 * MiB;
constexpr size_t WS_A = 276 * MiB;
constexpr size_t WS_XN = WS_A;
constexpr size_t WS_Q = WS_A + 72 * MiB;
constexpr size_t WS_K = WS_A + 104 * MiB;
constexpr size_t WS_V = WS_A + 113 * MiB;
constexpr size_t WS_U = WS_A + 122 * MiB;
constexpr size_t WS_VV = WS_A + 154 * MiB;
constexpr size_t WS_VSS = WS_A + 186 * MiB;
constexpr size_t WS_MIX = WS_A + 188 * MiB;
constexpr size_t WS_HID = WS_A;
constexpr size_t WS_YE = WS_WBF;
constexpr size_t WS_END = 532 * MiB;

struct Params {
    const float *x, *c, *ctx, *c_ctx, *w_mod, *b_mod, *g_mix, *g_ffn, *w_in, *q_gain, *k_gain, *v_gain, *w_s, *b_s, *w_out, *w_router, *w1, *w3, *w2, *g_final;
    float* out; unsigned char* ws;
};

__device__ __forceinline__ float silu_f(float v) { return v / (1.f + __expf(-v)); }
__device__ __forceinline__ float gelu_f(float v) { return 0.5f * v * (1.f + erff(v * 0.70710678118654752f)); }

__device__ __forceinline__ float block_sum_256(float v, float* red) {
#pragma unroll
    for (int o = 32; o > 0; o >>= 1) v += __shfl_xor(v, o);
    __syncthreads();
    if ((threadIdx.x & 63) == 0) red[threadIdx.x >> 6] = v;
    __syncthreads();
    return (red[0] + red[1]) + (red[2] + red[3]);
}

__global__ void nv_adaln(Params p) {
    const int idx = blockIdx.x * 256 + threadIdx.x;
    if (idx >= 17 * 6144) return;
    const int r = idx / 6144, n = idx % 6144;
    const float* cv = r < 16 ? p.c + r * DM : p.c_ctx;
    float acc = 0.f;
    for (int k = 0; k < DM; ++k) acc += silu_f(cv[k]) * p.w_mod[(size_t)k * 6144 + n];
    ((float*)(p.ws + WS_MOD))[idx] = acc + p.b_mod[n];
}
__global__ void nv_rope(Params p) {
    const int idx = blockIdx.x * 256 + threadIdx.x;
    const int t = idx >> 5, i = idx & 31;
    const int f = i & 15;
    const float inv = exp2f(-(float)f * (13.287712379549449f / 16.f));
    const float pos = (i < 16) ? (float)(t >> 6) : (float)(t & 63);
    const float ang = pos * inv;
    float* cs = (float*)(p.ws + WS_ROPE);
    cs[idx] = cosf(ang); cs[2048 * 32 + idx] = sinf(ang);
}
__global__ void nv_modulate(Params p) {
    __shared__ float red[4];
    const int row = blockIdx.x, tid = threadIdx.x;
    const float* xr; const float* mod;
    if (row < MLAT) { xr = p.x + (size_t)row * DM; mod = (const float*)(p.ws + WS_MOD) + (row / SEQ) * 6144; }
    else { xr = p.ctx + (size_t)(row - MLAT) * DM; mod = (const float*)(p.ws + WS_MOD) + 16 * 6144; }
    float v[4], ss = 0.f;
#pragma unroll
    for (int j = 0; j < 4; ++j) { v[j] = xr[tid + 256 * j]; ss += v[j] * v[j]; }
    const float tot = block_sum_256(ss, red);
    const float rstd = rsqrtf(tot * (1.f / DM) + EPS);
    bf16_t* o = (bf16_t*)(p.ws + WS_XN) + (size_t)row * DM;
#pragma unroll
    for (int j = 0; j < 4; ++j) { const int k = tid + 256 * j; o[k] = f2bf(v[j] * rstd * p.g_mix[k] * (1.f + mod[1024 + k]) + mod[k]); }
}

template <class P, bool DUAL>
__global__ void __launch_bounds__(256) nv_gemm(P pr) {
    __shared__ float As[16][65];
    __shared__ float Bs1[16][64];
    __shared__ float Bs3[DUAL ? 16 : 1][64];
    __shared__ float C1[64][65];
    __shared__ float C3[DUAL ? 64 : 1][65];
    const int row0 = blockIdx.y * 64, col0 = blockIdx.x * 64, tid = threadIdx.x;
    if (pr.skip(row0, col0)) return;
    const int tx = tid & 15, ty = tid >> 4;
    const float* B1 = pr.b1(row0); const float* B3 = DUAL ? pr.b3(row0) : nullptr;
    const int ldb = pr.ldb(), K = pr.K();
    float a1[4][4] = {}, a3[4][4] = {};
    for (int k0 = 0; k0 < K; k0 += 16) {
#pragma unroll
        for (int i = 0; i < 4; ++i) { const int e = tid + 256 * i, r = e >> 4, kk = e & 15; As[kk][r] = pr.a(row0 + r, k0 + kk); }
#pragma unroll
        for (int i = 0; i < 4; ++i) { const int e = tid + 256 * i, kk = e >> 6, cc = e & 63;
            Bs1[kk][cc] = B1[(size_t)(k0 + kk) * ldb + col0 + cc];
            if (DUAL) Bs3[kk][cc] = B3[(size_t)(k0 + kk) * ldb + col0 + cc]; }
        __syncthreads();
#pragma unroll
        for (int kk = 0; kk < 16; ++kk) {
            float av[4], bv[4], cv[4];
#pragma unroll
            for (int i = 0; i < 4; ++i) av[i] = As[kk][ty * 4 + i];
#pragma unroll
            for (int j = 0; j < 4; ++j) { bv[j] = Bs1[kk][tx * 4 + j]; cv[j] = DUAL ? Bs3[kk][tx * 4 + j] : 0.f; }
#pragma unroll
            for (int i = 0; i < 4; ++i)
#pragma unroll
                for (int j = 0; j < 4; ++j) { a1[i][j] += av[i] * bv[j]; if (DUAL) a3[i][j] += av[i] * cv[j]; }
        }
        __syncthreads();
    }
#pragma unroll
    for (int i = 0; i < 4; ++i)
#pragma unroll
        for (int j = 0; j < 4; ++j) { C1[ty * 4 + i][tx * 4 + j] = a1[i][j]; if (DUAL) C3[ty * 4 + i][tx * 4 + j] = a3[i][j]; }
    __syncthreads();
    pr.epilogue(C1, C3, row0, col0, tid);
}

struct InProjNv {
    Params p;
    __device__ bool skip(int row0, int col0) const { return row0 >= MLAT && !(col0 >= 512 && col0 < 768); }
    __device__ const float* b1(int) const { return p.w_in; }
    __device__ const float* b3(int) const { return nullptr; }
    __device__ int ldb() const { return DIN; }
    __device__ int K() const { return DM; }
    __device__ float a(int row, int k) const { return bf2f(((const bf16_t*)(p.ws + WS_XN))[(size_t)row * DM + k]); }
    __device__ void epilogue(float (*C)[65], float (*)[65], int row0, int col0, int tid) const {
        const float* cs = (const float*)(p.ws + WS_ROPE); const float* sn = cs + 2048 * 32;
        if (tid >= 64) return;
        const int r = tid, row = row0 + r;
        const bool lat = row < MLAT;
        int b, s;
        if (lat) { b = row / SEQ; s = row % SEQ; } else { const int rc = row - MLAT; b = rc / CTXL; s = SEQ + rc % CTXL; }
        if (col0 < 640) {
            const bool isq = col0 < 512;
            const float* gain = isq ? p.q_gain : p.k_gain;
            float ss = 0.f;
            for (int c = 0; c < 64; ++c) ss += C[r][c] * C[r][c];
            const float rstd = rsqrtf(ss * (1.f / 64.f) + EPS);
            bf16_t* o = isq ? (bf16_t*)(p.ws + WS_Q) + (size_t)row * DATT + col0
                            : (bf16_t*)(p.ws + WS_K) + ((size_t)b * NKEY + s) * DKV + (col0 - 512);
            const float sc = isq ? QSCALE : 1.f;
            for (int i = 0; i < 32; ++i) {
                const float y1 = C[r][i] * rstd * gain[i], y2 = C[r][i + 32] * rstd * gain[i + 32];
                float o1 = y1, o2 = y2;
                if (lat) { const float cv = cs[s * 32 + i], sv = sn[s * 32 + i]; o1 = y1 * cv - y2 * sv; o2 = y1 * sv + y2 * cv; }
                o[i] = f2bf(o1 * sc); o[i + 32] = f2bf(o2 * sc);
            }
        } else if (col0 < 768) {
            bf16_t* o = (bf16_t*)(p.ws + WS_V) + ((size_t)b * NKEY + s) * DKV + (col0 - 640);
            for (int c = 0; c < 64; ++c) o[c] = f2bf(C[r][c]);
        } else if (col0 < 1280) {
            bf16_t* o = (bf16_t*)(p.ws + WS_U) + (size_t)row * DGM + (col0 - 768);
            for (int c = 0; c < 64; ++c) o[c] = f2bf(gelu_f(C[r][c]));
        } else {
            bf16_t* o = (bf16_t*)(p.ws + WS_VV) + (size_t)row * DGM + (col0 - 1280);
            float ss = 0.f;
            for (int c = 0; c < 64; ++c) { const float g = gelu_f(C[r][c]); ss += g * g; o[c] = f2bf(g); }
            ((float*)(p.ws + WS_VSS))[(size_t)row * 8 + (col0 - 1280) / 64] = ss;
        }
    }
};

__global__ void __launch_bounds__(256) nv_attn(Params p) {
    __shared__ float ps[4][NKEY];
    const int wid = threadIdx.x >> 6, lane = threadIdx.x & 63;
    const int gq = blockIdx.x * 4 + wid;
    const int t = gq % SEQ, h = (gq / SEQ) % NQH, b = gq / (SEQ * NQH);
    const int kvh = h >> 2;
    const bf16_t* Q = (const bf16_t*)(p.ws + WS_Q) + ((size_t)(b * SEQ + t)) * DATT + h * HD;
    const bf16_t* K = (const bf16_t*)(p.ws + WS_K) + (size_t)b * NKEY * DKV + kvh * HD;
    const bf16_t* V = (const bf16_t*)(p.ws + WS_V) + (size_t)b * NKEY * DKV + kvh * HD;
    float q[64];
#pragma unroll
    for (int d = 0; d < 64; ++d) q[d] = bf2f(Q[d]);
    float mx = -1e30f;
    for (int j = lane; j < NKEY; j += 64) {
        const bf16_t* kr = K + (size_t)j * DKV; float s = 0.f;
#pragma unroll
        for (int d = 0; d < 64; ++d) s += q[d] * bf2f(kr[d]);
        ps[wid][j] = s; mx = fmaxf(mx, s);
    }
#pragma unroll
    for (int o = 32; o > 0; o >>= 1) mx = fmaxf(mx, __shfl_xor(mx, o));
    float sum = 0.f;
    for (int j = lane; j < NKEY; j += 64) { const float e = exp2f(ps[wid][j] - mx); ps[wid][j] = e; sum += e; }
#pragma unroll
    for (int o = 32; o > 0; o >>= 1) sum += __shfl_xor(sum, o);
    __syncthreads();
    float acc = 0.f;
    for (int j = 0; j < NKEY; ++j) acc += ps[wid][j] * bf2f(V[(size_t)j * DKV + lane]);
    ((bf16_t*)(p.ws + WS_MIX))[(size_t)(b * SEQ + t) * DM + h * HD + lane] = f2bf(acc / sum);
}
__global__ void __launch_bounds__(256) nv_sgu(Params p) {
    const int idx = blockIdx.x * 256 + threadIdx.x;
    const int col = idx & 511, row = idx >> 9;
    const int g = col >> 6, i = row & 127, base = row & ~127;
    const bf16_t* VV = (const bf16_t*)(p.ws + WS_VV); const float* VSS = (const float*)(p.ws + WS_VSS);
    const float* ws = p.w_s + ((size_t)g * CHUNK + i) * CHUNK;
    float acc = 0.f;
    for (int j = 0; j < CHUNK; ++j) {
        const int rj = base + j; const float* pss = VSS + (size_t)rj * 8;
        const float ss = ((pss[0] + pss[1]) + (pss[2] + pss[3])) + ((pss[4] + pss[5]) + (pss[6] + pss[7]));
        const float rstd = rsqrtf(ss * (1.f / DGM) + EPS);
        acc += ws[j] * (bf2f(VV[(size_t)rj * DGM + col]) * rstd);
    }
    const float mixed = acc * p.v_gain[col] + p.b_s[g * CHUNK + i];
    const float u = bf2f(((const bf16_t*)(p.ws + WS_U))[(size_t)row * DGM + col]);
    ((bf16_t*)(p.ws + WS_MIX))[(size_t)row * DM + DATT + col] = f2bf(u * mixed);
}
struct OutProjNv {
    Params p;
    __device__ bool skip(int, int) const { return false; }
    __device__ const float* b1(int) const { return p.w_out; }
    __device__ const float* b3(int) const { return nullptr; }
    __device__ int ldb() const { return DM; }
    __device__ int K() const { return DM; }
    __device__ float a(int row, int k) const { return bf2f(((const bf16_t*)(p.ws + WS_MIX))[(size_t)row * DM + k]); }
    __device__ void epilogue(float (*C)[65], float (*)[65], int row0, int col0, int tid) const {
        const float* mod = (const float*)(p.ws + WS_MOD);
        for (int e = tid; e < 64 * 64; e += 256) { const int r = e >> 6, c = e & 63, row = row0 + r, col = col0 + c;
            const float gt1 = mod[(row / SEQ) * 6144 + 2048 + col];
            p.out[(size_t)row * DM + col] = p.x[(size_t)row * DM + col] + gt1 * C[r][c]; }
    }
};
__global__ void __launch_bounds__(256) nv_router(Params p) {
    __shared__ float red[4];
    __shared__ float part[16][257];
    const int row = blockIdx.x, tid = threadIdx.x, b = row / SEQ, t = row % SEQ;
    const float* xr = p.out + (size_t)row * DM; const float* mod = (const float*)(p.ws + WS_MOD) + b * 6144;
    float v[4], ss = 0.f;
#pragma unroll
    for (int j = 0; j < 4; ++j) { v[j] = xr[tid + 256 * j]; ss += v[j] * v[j]; }
    const float tot = block_sum_256(ss, red);
    const float rstd = rsqrtf(tot * (1.f / DM) + EPS);
    float lg[16];
#pragma unroll
    for (int e = 0; e < 16; ++e) lg[e] = 0.f;
    bf16_t* o = (bf16_t*)(p.ws + WS_H2) + (size_t)row * DM;
#pragma unroll
    for (int j = 0; j < 4; ++j) { const int k = tid + 256 * j; const float h = v[j] * rstd * p.g_ffn[k] * (1.f + mod[4096 + k]) + mod[3072 + k];
        o[k] = f2bf(h);
#pragma unroll
        for (int e = 0; e < 16; ++e) lg[e] += h * p.w_router[k * 16 + e]; }
#pragma unroll
    for (int e = 0; e < 16; ++e) part[e][tid] = lg[e];
    __syncthreads();
    if (tid < 16) { float s = 0.f; for (int i = 0; i < 256; ++i) s += part[tid][i]; part[tid][256] = s; }
    __syncthreads();
    if (tid < 16) { float mx = -1e30f; for (int e = 0; e < 16; ++e) mx = fmaxf(mx, part[e][256]);
        float den = 0.f; for (int e = 0; e < 16; ++e) den += __expf(part[e][256] - mx);
        ((float*)(p.ws + WS_AFF))[((size_t)b * NE + tid) * SEQ + t] = __expf(part[tid][256] - mx) / den; }
}
__global__ void __launch_bounds__(256) nv_topk(Params p) {
    __shared__ float v[SEQ];
    const int be = blockIdx.x, b = be / NE, e = be % NE, tid = threadIdx.x;
    const float* aff = (const float*)(p.ws + WS_AFF) + (size_t)be * SEQ;
    for (int i = tid; i < SEQ; i += 256) v[i] = aff[i];
    __syncthreads();
    int* idx = (int*)(p.ws + WS_IDX) + be * CAP; float* gate = (float*)(p.ws + WS_GATE) + (e * NB + b) * CAP; int* inv = (int*)(p.ws + WS_INV);
    for (int t = tid; t < SEQ; t += 256) { const float mine = v[t]; int rank = 0;
        for (int j = 0; j < SEQ; ++j) { const float o = v[j]; rank += (o > mine || (o == mine && j < t)) ? 1 : 0; }
        if (rank < CAP) { idx[rank] = t; gate[rank] = mine; inv[(size_t)(b * SEQ + t) * NE + e] = (e * NB + b) * CAP + rank; }
        else inv[(size_t)(b * SEQ + t) * NE + e] = -1; }
}
struct Ffn1Nv {
    Params p;
    __device__ bool skip(int, int) const { return false; }
    __device__ const float* b1(int row0) const { return p.w1 + (size_t)(row0 / (NB * CAP)) * DM * FF; }
    __device__ const float* b3(int row0) const { return p.w3 + (size_t)(row0 / (NB * CAP)) * DM * FF; }
    __device__ int ldb() const { return FF; }
    __device__ int K() const { return DM; }
    __device__ float a(int slot, int k) const { const int grp = slot / CAP, j = slot % CAP, e = grp / NB, b = grp % NB;
        const int t = ((const int*)(p.ws + WS_IDX))[(b * NE + e) * CAP + j];
        return bf2f(((const bf16_t*)(p.ws + WS_H2))[(size_t)(b * SEQ + t) * DM + k]); }
    __device__ void epilogue(float (*C1)[65], float (*C3)[65], int row0, int col0, int tid) const {
        bf16_t* hid = (bf16_t*)(p.ws + WS_HID);
        for (int e = tid; e < 64 * 64; e += 256) { const int r = e >> 6, c = e & 63;
            hid[(size_t)(row0 + r) * FF + col0 + c] = f2bf(silu_f(C1[r][c]) * C3[r][c]); }
    }
};
struct Ffn2Nv {
    Params p;
    __device__ bool skip(int, int) const { return false; }
    __device__ const float* b1(int row0) const { return p.w2 + (size_t)(row0 / (NB * CAP)) * FF * DM; }
    __device__ const float* b3(int) const { return nullptr; }
    __device__ int ldb() const { return DM; }
    __device__ int K() const { return FF; }
    __device__ float a(int slot, int k) const { return bf2f(((const bf16_t*)(p.ws + WS_HID))[(size_t)slot * FF + k]); }
    __device__ void epilogue(float (*C)[65], float (*)[65], int row0, int col0, int tid) const {
        bf16_t* ye = (bf16_t*)(p.ws + WS_YE); const float* gate = (const float*)(p.ws + WS_GATE);
        for (int e = tid; e < 64 * 64; e += 256) { const int r = e >> 6, c = e & 63;
            ye[(size_t)(row0 + r) * DM + col0 + c] = f2bf(C[r][c] * gate[row0 + r]); }
    }
};
__global__ void __launch_bounds__(256) nv_final(Params p) {
    __shared__ float red[4];
    const int row = blockIdx.x, tid = threadIdx.x, b = row / SEQ;
    const float* mod = (const float*)(p.ws + WS_MOD) + b * 6144;
    const int* inv = (const int*)(p.ws + WS_INV) + (size_t)row * NE; const bf16_t* ye = (const bf16_t*)(p.ws + WS_YE);
    float m[4] = {0.f, 0.f, 0.f, 0.f};
    for (int e = 0; e < NE; ++e) { const int s = inv[e]; if (s >= 0) {
#pragma unroll
        for (int j = 0; j < 4; ++j) m[j] += bf2f(ye[(size_t)s * DM + tid + 256 * j]); } }
    float v[4], ss = 0.f;
#pragma unroll
    for (int j = 0; j < 4; ++j) { const int k = tid + 256 * j; v[j] = p.out[(size_t)row * DM + k] + mod[5120 + k] * m[j]; ss += v[j] * v[j]; }
    const float tot = block_sum_256(ss, red);
    const float rstd = rsqrtf(tot * (1.f / DM) + EPS);
#pragma unroll
    for (int j = 0; j < 4; ++j) { const int k = tid + 256 * j; p.out[(size_t)row * DM + k] = v[j] * rstd * p.g_final[k]; }
}

extern "C" void kernel_launch(void* const* d_in, const int* in_sizes, int n_in, void* d_out, int out_size, void* d_ws, size_t ws_size, hipStream_t stream) {
    if (n_in != 20 || ws_size < WS_END) return;
    Params p{};
    const float** f = (const float**)&p;
    for (int i = 0; i < 20; ++i) f[i] = (const float*)d_in[i];
    p.out = (float*)d_out; p.ws = (unsigned char*)d_ws;
    nv_adaln<<<(17 * 6144 + 255) / 256, 256, 0, stream>>>(p);
    nv_rope<<<2048 * 32 / 256, 256, 0, stream>>>(p);
    nv_modulate<<<MALL, 256, 0, stream>>>(p);
    nv_gemm<InProjNv, false><<<dim3(DIN / 64, MALL / 64), 256, 0, stream>>>(InProjNv{p});
    nv_attn<<<NB * NQH * SEQ / 4, 256, 0, stream>>>(p);
    nv_sgu<<<MLAT * DGM / 256, 256, 0, stream>>>(p);
    nv_gemm<OutProjNv, false><<<dim3(DM / 64, MLAT / 64), 256, 0, stream>>>(OutProjNv{p});
    nv_router<<<MLAT, 256, 0, stream>>>(p);
    nv_topk<<<NB * NE, 256, 0, stream>>>(p);
    nv_gemm<Ffn1Nv, true><<<dim3(FF / 64, NSLOT / 64), 256, 0, stream>>>(Ffn1Nv{p});
    nv_gemm<Ffn2Nv, false><<<dim3(DM / 64, NSLOT / 64), 256, 0, stream>>>(Ffn2Nv{p});
    nv_final<<<MLAT, 256, 0, stream>>>(p);
}
```

```cpp
#include <hip/hip_runtime.h>
#include <stdint.h>

typedef unsigned short bf16_t;
__device__ __forceinline__ float bf2f(bf16_t v) { return __uint_as_float(((unsigned)v) << 16); }
__device__ __forceinline__ bf16_t f2bf(float f) { unsigned u = __float_as_uint(f); return (bf16_t)((u + 0x7fffu + ((u >> 16) & 1u)) >> 16); }

constexpr int NB = 16, SEQ = 2048, DM = 1024, CTXL = 256, NKEY = SEQ + CTXL;
constexpr int HD = 64, NQH = 8, NKVH = 2, DATT = 512, DKV = 128, DGM = 512, CHUNK = 128, NGRP = 8;
constexpr int DIN = 1792, NE = 16, CAP = 256, FF = 2048;
constexpr int MLAT = NB * SEQ;
constexpr int MCTX = NB * CTXL;
constexpr int MALL = MLAT + MCTX;
constexpr int NSLOT = NB * NE * CAP;
constexpr float EPS = 1e-6f;
constexpr float QSCALE = 0.125f * 1.4426950408889634f;

constexpr size_t MiB = 1u << 20;
constexpr size_t WS_MOD = 1 * MiB;
constexpr size_t WS_ROPE = 2 * MiB;
constexpr size_t WS_AFF = 3 * MiB;
constexpr size_t WS_IDX = 5 * MiB;
constexpr size_t WS_GATE = 6 * MiB;
constexpr size_t WS_INV = 7 * MiB;
constexpr size_t WS_WBF = 10 * MiB;
constexpr size_t WS_H2 = 210 * MiB;
constexpr size_t WS_A = 276 * MiB;
constexpr size_t WS_XN = WS_A;
constexpr size_t WS_Q = WS_A + 72 * MiB;
constexpr size_t WS_K = WS_A + 104 * MiB;
constexpr size_t WS_V = WS_A + 113 * MiB;
constexpr size_t WS_U = WS_A + 122 * MiB;
constexpr size_t WS_VV = WS_A + 154 * MiB;
constexpr size_t WS_VSS = WS_A + 186 * MiB;
constexpr size_t WS_MIX = WS_A + 188 * MiB;
constexpr size_t WS_X1B = WS_MIX;
constexpr size_t WS_HID = WS_A;
constexpr size_t WS_YE = WS_WBF + 70 * MiB;
constexpr size_t WS_PROJ = WS_WBF + 134 * MiB;
constexpr size_t WS_END = 532 * MiB;

struct Params {
    const float *x, *c, *ctx, *c_ctx, *w_mod, *b_mod, *g_mix, *g_ffn, *w_in, *q_gain, *k_gain, *v_gain, *w_s, *b_s, *w_out, *w_router, *w1, *w3, *w2, *g_final;
    float* out; unsigned char* ws;
};

__device__ __forceinline__ float silu_f(float v) { return v / (1.f + __expf(-v)); }
__device__ __forceinline__ float gelu_f(float v) { return 0.5f * v * (1.f + erff(v * 0.70710678118654752f)); }

#include <hip/hip_cooperative_groups.h>
namespace cg = cooperative_groups;

#define LAS __attribute__((address_space(3)))
#define GAS __attribute__((address_space(1)))
typedef short bf16x8 __attribute__((ext_vector_type(8)));
typedef float f32x4 __attribute__((ext_vector_type(4)));
typedef float f32x2 __attribute__((ext_vector_type(2)));
typedef unsigned u32x4 __attribute__((ext_vector_type(4)));
typedef unsigned u32x2 __attribute__((ext_vector_type(2)));

__device__ __forceinline__ unsigned cvt_pk_bf16(float lo, float hi) {
    typedef __bf16 bf16x2_t __attribute__((ext_vector_type(2)));
    f32x2 v = {lo, hi}; bf16x2_t b = __builtin_convertvector(v, bf16x2_t); return __builtin_bit_cast(unsigned, b);
}
__device__ __forceinline__ float fast_silu(float v) { return v * __builtin_amdgcn_rcpf(1.f + __expf(-v)); }
__device__ __forceinline__ float fast_gelu(float v) {
    const float av = fabsf(v), t = __builtin_amdgcn_rcpf(av * 0.2316418882f + 1.0f);
    float q = t * 0.5307027145f + (-0.7265760135f); q = q * t + 0.7107068705f; q = q * t + (-0.142248368f); q = q * t + 0.127414796f; q = q * t;
    const float e = __builtin_amdgcn_exp2f((v * v) * (-0.72134752044f));
    const float m = v * (q * e);
    return v < 0.f ? m : v - m;
}

namespace pg8 {
constexpr int BM = 256, BK = 64, HALF = 128, HTB = HALF * BK * 2  , STAGE_BYTES = 8 * HTB, NXCD = 8, WGM = 8;
__host__ __device__ __forceinline__ int lds_byte(int r, int c) { const int st = (r >> 4) * 2 + (c >> 5), rr = r & 15, cc = c & 31, ob = rr * 64 + cc * 2; return st * 1024 + (ob ^ (((ob >> 9) & 1) << 5)); }
__host__ __device__ __forceinline__ void stage_rc(int b, int& R, int& C) { const int st = b / 1024, sb = b % 1024, swz = sb ^ (((sb >> 9) & 1) << 5); R = (st >> 1) * 16 + swz / 64; C = (st & 1) * 32 + (swz % 64) / 2; }
__host__ __device__ __forceinline__ int perm32(int rho) { const int n = rho >> 4, i = rho & 15; return 8 * (i >> 2) + 4 * n + (i & 3); }

struct Unit { int pm, pn; };
typedef int v8i __attribute__((ext_vector_type(8)));
typedef int v4i __attribute__((ext_vector_type(4)));
__device__ __forceinline__ bf16x8 lo8(v8i v) { return __builtin_bit_cast(bf16x8, __builtin_shufflevector(v, v, 0, 1, 2, 3)); }
__device__ __forceinline__ bf16x8 hi8(v8i v) { return __builtin_bit_cast(bf16x8, __builtin_shufflevector(v, v, 4, 5, 6, 7)); }

struct StaticOrder {
    int nM, nN, nwg, G, c, i0, i1, wgm;
    __device__ void init(int M, int N, int G_, int c_, int i0_ = 0, int i1_ = 1 << 30, int wgm_ = WGM) { nM = M / BM; nN = N / BM; nwg = nM * nN; G = G_; c = c_; i0 = i0_; i1 = i1_; wgm = wgm_; }
    __device__ bool next(int j, Unit& u) const {
        const int i = i0 + j; if (i >= i1) return false;
        const long L = (long)i * G + c; if (L >= nwg) return false;
        int wgid = (int)L; { const int q = nwg / NXCD, r = nwg % NXCD, xcd = wgid % NXCD, off = wgid / NXCD; wgid = (xcd < r ? xcd * (q + 1) : r * (q + 1) + (xcd - r) * q) + off; }
        const int nig = wgm * nN, gid = wgid / nig, fm = gid * wgm, gsz = (nM - fm) < wgm ? (nM - fm) : wgm;
        u.pm = fm + ((wgid % nig) % gsz); u.pn = (wgid % nig) / gsz; return true;
    }
};

template <class Prob, class Epi, class Sched, bool ALIGN_EPI>
__device__ __forceinline__ void gemm_phase(LAS unsigned char* lds, const Prob& P, const Sched& S, const Epi& E) {
    const int tid = threadIdx.x, wid = __builtin_amdgcn_readfirstlane(tid >> 6), lane = tid & 63, wr = wid >> 2, wc = wid & 3, fr = lane & 15, fq = lane >> 4;
    constexpr bool FP8 = Prob::FP8;
    constexpr int K = Prob::K, PB = FP8 ? K : 2 * K  , nt = PB / 128;
    Unit cur, nxt; int ui = 0;
    if (!S.next(0, cur)) return;
    unsigned voffA[2][2], voffB[2];
#pragma unroll
    for (int i = 0; i < 2; ++i) { int R, C; stage_rc(tid * 16 + i * 8192, R, C); const int Rb = Epi::PERM ? ((R & ~31) + perm32(R & 31)) : R;
        voffA[0][i] = P.a_offs(cur, R, C); voffA[1][i] = P.a_offs(cur, R + HALF, C); voffB[i] = (unsigned)(Rb * PB + C * 2); }
    const size_t kstep = (size_t)(BK * 2);
    const size_t hstepB = (size_t)HALF * PB;
    const unsigned ldsw = (unsigned)wid * 1024u;
    const int aoff = lds_byte(wr * 64 + fr, fq * 8), boff = lds_byte(wc * 32 + fr, fq * 8);
#define PG8_SA(b, h) (((b) * 2 + (h)) * HTB)
#define PG8_SB(b, h) ((4 + (b) * 2 + (h)) * HTB)
#define PG8_STAGE(bufoff, gbase, voff) do { _Pragma("unroll") for (int _i = 0; _i < 2; ++_i) \
        __builtin_amdgcn_global_load_lds((const unsigned*)((const char*)(gbase) + (voff)[_i]), (LAS unsigned*)(lds + (bufoff) + ldsw + _i * 8192), 16, 0, 0); } while (0)
#define PG8_STAGE_A(b, h, gbase) PG8_STAGE(PG8_SA(b, h), gbase, voffA[h])
#define PG8_STAGE_B(b, h, gbase) PG8_STAGE(PG8_SB(b, h), (gbase) + (h) * hstepB, voffB)
#define PG8_LD8(base) __builtin_shufflevector(*(const LAS v4i*)(base), *(const LAS v4i*)((base) + 1024), 0, 1, 2, 3, 4, 5, 6, 7)
#define PG8_LDA(dst, b, h) do { _Pragma("unroll") for (int m = 0; m < 4; ++m) dst[m] = PG8_LD8(lds + PG8_SA(b, h) + aoff + m * 2048); } while (0)
#define PG8_LDB(dst, b, h) do { _Pragma("unroll") for (int n = 0; n < 2; ++n) dst[n] = PG8_LD8(lds + PG8_SB(b, h) + boff + n * 2048); } while (0)
#define PG8_MMA(ai, bj, At, Bt) do { __builtin_amdgcn_s_setprio(1); _Pragma("unroll") for (int m = 0; m < 4; ++m) _Pragma("unroll") for (int n = 0; n < 2; ++n) { \
        if constexpr (FP8) asm volatile("v_mfma_scale_f32_16x16x128_f8f6f4 %0, %1, %2, %0, %3, %4 op_sel_hi:[0,0,0]" : "+v"(acc[ai][bj][m][n]) : "v"(Bt[n]), "v"(At[m]), "v"(sclB), "v"(sclA)); \
        else { acc[ai][bj][m][n] = __builtin_amdgcn_mfma_f32_16x16x32_bf16(lo8(Bt[n]), lo8(At[m]), acc[ai][bj][m][n], 0, 0, 0); \
               acc[ai][bj][m][n] = __builtin_amdgcn_mfma_f32_16x16x32_bf16(hi8(Bt[n]), hi8(At[m]), acc[ai][bj][m][n], 0, 0, 0); } } \
        __builtin_amdgcn_s_setprio(0); } while (0)
#define PG8_WAIT_V(n) asm volatile("s_waitcnt vmcnt(" #n ")" ::: "memory")
#define PG8_WAIT_L(n) asm volatile("s_waitcnt lgkmcnt(" #n ")" ::: "memory")
#define PG8_BAR __builtin_amdgcn_s_barrier()
#define PG8_SCHED __builtin_amdgcn_sched_barrier(0)
    f32x4 acc[2][2][4][2];
#pragma unroll
    for (int a = 0; a < 2; ++a)
#pragma unroll
        for (int b = 0; b < 2; ++b)
#pragma unroll
            for (int m = 0; m < 4; ++m)
#pragma unroll
                for (int n = 0; n < 2; ++n) acc[a][b][m][n] = (f32x4){0.f, 0.f, 0.f, 0.f};
    const int sclA = Prob::SCALE_A, sclB = Prob::SCALE_B;
    v8i At[4], B0[2], B1[2];
    const char* cA = P.a_base(cur); const char* cB = P.b_base(cur);
    PG8_STAGE_B(0, 0, cB); PG8_STAGE_B(0, 1, cB); PG8_STAGE_A(0, 0, cA); PG8_STAGE_A(0, 1, cA);
    if (wr == 1) PG8_BAR;
    PG8_WAIT_V(2); PG8_BAR;
    PG8_STAGE_B(1, 0, cB + kstep); PG8_STAGE_A(1, 0, cA + kstep); PG8_STAGE_B(1, 1, cB + kstep);
    PG8_WAIT_V(6); PG8_BAR;
    for (;;) {
        const bool has_next = S.next(ui + 1, nxt);
        const char* nA = has_next ? P.a_base(nxt) : cA; const char* nB = has_next ? P.b_base(nxt) : cB;
#pragma unroll 1
        for (int t = 0; t < nt; t += 2) {
            const bool last = (t == nt - 2);
            const char* a1 = cA + (size_t)(t + 1) * kstep;
            const char* a2 = last ? nA : cA + (size_t)(t + 2) * kstep; const char* b2 = last ? nB : cB + (size_t)(t + 2) * kstep;
            const char* a3 = a2 + kstep; const char* b3 = b2 + kstep;
            PG8_LDB(B0, 0, 0); PG8_LDB(B1, 0, 1); PG8_SCHED; PG8_LDA(At, 0, 0); PG8_STAGE_A(1, 1, a1);
            PG8_WAIT_V(8); PG8_WAIT_L(0); PG8_BAR; PG8_MMA(0, 0, At, B0); PG8_MMA(0, 1, At, B1); PG8_BAR; PG8_SCHED;
            PG8_LDA(At, 0, 1); PG8_STAGE_B(0, 0, b2); PG8_STAGE_B(0, 1, b2); PG8_STAGE_A(0, 0, a2);
            PG8_WAIT_V(8); PG8_WAIT_L(0); PG8_BAR; PG8_MMA(1, 0, At, B0); PG8_MMA(1, 1, At, B1); PG8_BAR; PG8_SCHED;
            PG8_LDB(B0, 1, 0); PG8_LDB(B1, 1, 1); PG8_SCHED; PG8_LDA(At, 1, 0); PG8_STAGE_A(0, 1, a2);
            PG8_WAIT_V(8); PG8_WAIT_L(0); PG8_BAR; PG8_MMA(0, 0, At, B0); PG8_MMA(0, 1, At, B1); PG8_BAR; PG8_SCHED;
            PG8_LDA(At, 1, 1); PG8_STAGE_B(1, 0, b3); PG8_STAGE_B(1, 1, b3); PG8_STAGE_A(1, 0, a3);
            PG8_WAIT_V(8); PG8_WAIT_L(0); PG8_BAR; PG8_MMA(1, 0, At, B0); PG8_MMA(1, 1, At, B1); PG8_BAR; PG8_SCHED;
        }
        if constexpr (ALIGN_EPI) { if (wr == 0) PG8_BAR; }
        if constexpr (FP8) {
#pragma unroll
            for (int a = 0; a < 2; ++a)
#pragma unroll
                for (int b = 0; b < 2; ++b) asm volatile("s_nop 15\n\ts_nop 7" : "+v"(acc[a][b][0][0]), "+v"(acc[a][b][0][1]), "+v"(acc[a][b][1][0]), "+v"(acc[a][b][1][1]), "+v"(acc[a][b][2][0]), "+v"(acc[a][b][2][1]), "+v"(acc[a][b][3][0]), "+v"(acc[a][b][3][1]));
        }
        E(acc, cur, wr, wc, fr, fq);
        if (!has_next) break;
#pragma unroll
        for (int a = 0; a < 2; ++a)
#pragma unroll
            for (int b = 0; b < 2; ++b)
#pragma unroll
                for (int m = 0; m < 4; ++m)
#pragma unroll
                    for (int n = 0; n < 2; ++n) acc[a][b][m][n] = (f32x4){0.f, 0.f, 0.f, 0.f};
        cur = nxt; cA = nA; cB = nB; ++ui;
        if constexpr (ALIGN_EPI) { if (wr == 1) PG8_BAR; }
    }
    PG8_WAIT_V(0);
    if constexpr (!ALIGN_EPI) { if (wr == 0) PG8_BAR; }
    PG8_BAR;
#undef PG8_SA
#undef PG8_SB
#undef PG8_STAGE
#undef PG8_STAGE_A
#undef PG8_STAGE_B
#undef PG8_LDA
#undef PG8_LD8
#undef PG8_LDB
#undef PG8_MMA
#undef PG8_WAIT_V
#undef PG8_WAIT_L
#undef PG8_BAR
#undef PG8_SCHED
}
}

constexpr size_t WS_WIN_T = WS_WBF;
constexpr size_t WS_WOUT_T = WS_WIN_T + (size_t)DIN * DM * 2;
constexpr size_t WS_WS_B = WS_WOUT_T + (size_t)DM * DM * 2;
constexpr size_t WS_W2_T = WS_WS_B + (size_t)NGRP * CHUNK * CHUNK * 2;
constexpr size_t WS_W13_T = WS_WBF + 70 * MiB;
static_assert(WS_W2_T + (size_t)NE * DM * FF * 2 <= WS_W13_T && WS_W13_T + (size_t)NE * 2 * FF * DM * 2 <= WS_H2, "weight copies");

constexpr float W8_SCALE = 256.f, A8_SCALE = 8.f;
constexpr int E8M0_W = 0x77777777  , E8M0_A = 0x7c7c7c7c  ;
__device__ __forceinline__ unsigned pk4_fp8(float a, float b, float c, float d, float s) {
    a = fminf(fmaxf(a * s, -448.f), 448.f); b = fminf(fmaxf(b * s, -448.f), 448.f); c = fminf(fmaxf(c * s, -448.f), 448.f); d = fminf(fmaxf(d * s, -448.f), 448.f);
    int w = __builtin_amdgcn_cvt_pk_fp8_f32(a, b, 0, false); w = __builtin_amdgcn_cvt_pk_fp8_f32(c, d, w, true); return (unsigned)w;
}
struct ProbFfn1 {
    static constexpr int K = DM; static constexpr bool FP8 = true; static constexpr int SCALE_A = E8M0_A, SCALE_B = E8M0_W;
    const unsigned char* ws;
    __device__ __forceinline__ const char* a_base(const pg8::Unit& u) const { return (const char*)(ws + WS_H2) + (size_t)(u.pm % NB) * SEQ * DM; }
    __device__ __forceinline__ const char* b_base(const pg8::Unit& u) const { return (const char*)(ws + WS_W13_T) + ((size_t)(u.pm / NB) * 16 + u.pn) * (size_t)256 * DM; }
    __device__ __forceinline__ unsigned a_offs(const pg8::Unit& u, int R, int C) const {
        const int e = u.pm / NB, b = u.pm % NB; const int t = ((const int*)(ws + WS_IDX))[(b * NE + e) * CAP + R];
        return (unsigned)(t * DM + C * 2); }
};
struct EpiFfn1 {
    static constexpr bool PERM = true;
    unsigned char* hid;
    __device__ __forceinline__ void operator()(const f32x4 (&acc)[2][2][4][2], const pg8::Unit& u, int wr, int wc, int fr, int fq) const {
        const int row0 = u.pm * 256 + wr * 64 + fr, col0 = u.pn * 128 + wc * 32 + 8 * fq;
#pragma unroll
        for (int ai = 0; ai < 2; ++ai)
#pragma unroll
            for (int m = 0; m < 4; ++m) {
                const f32x4 a0 = acc[ai][0][m][0], a1 = acc[ai][0][m][1], g0 = acc[ai][1][m][0], g1 = acc[ai][1][m][1];
                u32x2 w;
                w.x = pk4_fp8(fast_silu(a0[0]) * g0[0], fast_silu(a0[1]) * g0[1], fast_silu(a0[2]) * g0[2], fast_silu(a0[3]) * g0[3], A8_SCALE);
                w.y = pk4_fp8(fast_silu(a1[0]) * g1[0], fast_silu(a1[1]) * g1[1], fast_silu(a1[2]) * g1[2], fast_silu(a1[3]) * g1[3], A8_SCALE);
                *(u32x2*)(hid + (size_t)(row0 + ai * 128 + m * 16) * FF + col0) = w;
            }
    }
};
struct ProbFfn2 {
    static constexpr int K = FF; static constexpr bool FP8 = true; static constexpr int SCALE_A = E8M0_A, SCALE_B = E8M0_W;
    const unsigned char* ws;
    __device__ __forceinline__ const char* a_base(const pg8::Unit& u) const { return (const char*)(ws + WS_HID) + (size_t)u.pm * 256 * FF; }
    __device__ __forceinline__ const char* b_base(const pg8::Unit& u) const { return (const char*)(ws + WS_W2_T) + ((size_t)(u.pm / NB) * 4 + u.pn) * (size_t)256 * FF; }
    __device__ __forceinline__ unsigned a_offs(const pg8::Unit&, int R, int C) const { return (unsigned)(R * FF + C * 2); }
};
constexpr float YE8_SCALE = 64.f;
struct EpiFfn2 {
    static constexpr bool PERM = true;
    unsigned char* ye; const float* gate;
    __device__ __forceinline__ void operator()(const f32x4 (&acc)[2][2][4][2], const pg8::Unit& u, int wr, int wc, int fr, int fq) const {
        const int row0 = u.pm * 256 + wr * 64 + fr, col0 = u.pn * 256 + wc * 32 + 8 * fq;
#pragma unroll
        for (int ai = 0; ai < 2; ++ai)
#pragma unroll
            for (int m = 0; m < 4; ++m) { const int row = row0 + ai * 128 + m * 16; const float g = gate[row] * YE8_SCALE;
#pragma unroll
                for (int bj = 0; bj < 2; ++bj) { const f32x4 v0 = acc[ai][bj][m][0], v1 = acc[ai][bj][m][1];
                    u32x2 w; w.x = pk4_fp8(v0[0], v0[1], v0[2], v0[3], g); w.y = pk4_fp8(v1[0], v1[1], v1[2], v1[3], g);
                    *(u32x2*)(ye + (size_t)row * DM + col0 + bj * 128) = w; } }
    }
};

struct ProbInProj {
    static constexpr int K = DM; static constexpr bool FP8 = false; static constexpr int SCALE_A = 0, SCALE_B = 0;
    const unsigned char* ws;
    __device__ __forceinline__ const char* a_base(const pg8::Unit& u) const { return (const char*)(ws + WS_XN) + (size_t)u.pm * 256 * DM * 2; }
    __device__ __forceinline__ const char* b_base(const pg8::Unit& u) const { return (const char*)(ws + WS_WIN_T) + (size_t)u.pn * 256 * DM * 2; }
    __device__ __forceinline__ unsigned a_offs(const pg8::Unit&, int R, int C) const { return (unsigned)(R * DM + C) * 2u; }
};
struct InProjOrder {
    pg8::StaticOrder so; int G, c;
    __device__ void init(int G_, int c_) { so.init(MLAT, DIN, G_, c_); G = G_; c = c_; }
    __device__ bool next(int j, pg8::Unit& u) const {
        const int L = j * G + c;
        if (L < 896) return so.next(j, u);
        if (L < 896 + MCTX / 256) { u.pm = MLAT / 256 + (L - 896); u.pn = 2; return true; }
        return false;
    }
};
struct EpiInProj {
    static constexpr bool PERM = true;
    unsigned char* ws; const float* q_gain; const float* k_gain;
    __device__ __forceinline__ void operator()(const f32x4 (&acc)[2][2][4][2], const pg8::Unit& u, int wr, int wc, int fr, int fq) const {
        const int T = u.pn, rbase = u.pm * 256 + wr * 64 + fr;
        if (T <= 2) {
            const bool lat = u.pm < MLAT / 256;
            if (T == 2 && wc >= 2) {
                bf16_t* V = (bf16_t*)(ws + WS_V);
#pragma unroll
                for (int ai = 0; ai < 2; ++ai)
#pragma unroll
                    for (int m = 0; m < 4; ++m) { const int row = rbase + ai * 128 + m * 16; int b, s;
                        if (lat) { b = row >> 11; s = row & 2047; } else { const int rc = row - MLAT; b = rc >> 8; s = SEQ + (rc & 255); }
                        bf16_t* dst = V + ((size_t)b * NKEY + s) * DKV + (wc - 2) * 64 + 8 * fq;
#pragma unroll
                        for (int bj = 0; bj < 2; ++bj) { const f32x4 v0 = acc[ai][bj][m][0], v1 = acc[ai][bj][m][1];
                            u32x4 w; w.x = cvt_pk_bf16(v0[0], v0[1]); w.y = cvt_pk_bf16(v0[2], v0[3]); w.z = cvt_pk_bf16(v1[0], v1[1]); w.w = cvt_pk_bf16(v1[2], v1[3]);
                            *(u32x4*)(dst + 32 * bj) = w; } }
            } else {
                const bool isq = T < 2;
                const float* gain = isq ? q_gain : k_gain;
                const f32x4 g00 = *(const f32x4*)(gain + 8 * fq), g01 = *(const f32x4*)(gain + 8 * fq + 4), g10 = *(const f32x4*)(gain + 32 + 8 * fq), g11 = *(const f32x4*)(gain + 32 + 8 * fq + 4);
                const float* cs = (const float*)(ws + WS_ROPE); const float* sn = cs + 2048 * 32;
                const float osc = isq ? QSCALE : 1.f;
#pragma unroll
                for (int ai = 0; ai < 2; ++ai)
#pragma unroll
                    for (int m = 0; m < 4; ++m) { const int row = rbase + ai * 128 + m * 16; int b, s;
                        if (lat) { b = row >> 11; s = row & 2047; } else { const int rc = row - MLAT; b = rc >> 8; s = SEQ + (rc & 255); }
                        const f32x4 a00 = acc[ai][0][m][0], a01 = acc[ai][0][m][1], a10 = acc[ai][1][m][0], a11 = acc[ai][1][m][1];
                        float ss = 0.f;
#pragma unroll
                        for (int e = 0; e < 4; ++e) ss += (a00[e] * a00[e] + a01[e] * a01[e]) + (a10[e] * a10[e] + a11[e] * a11[e]);
                        ss += __shfl_xor(ss, 16); ss += __shfl_xor(ss, 32);
                        const float rstd = rsqrtf(ss * (1.f / 64.f) + EPS) ;
                        f32x4 y00 = a00 * g00 * rstd, y01 = a01 * g01 * rstd, y10 = a10 * g10 * rstd, y11 = a11 * g11 * rstd;
                        if (lat) {
                            const f32x4 c0 = *(const f32x4*)(cs + s * 32 + 8 * fq), c1 = *(const f32x4*)(cs + s * 32 + 8 * fq + 4), s0 = *(const f32x4*)(sn + s * 32 + 8 * fq), s1 = *(const f32x4*)(sn + s * 32 + 8 * fq + 4);
                            const f32x4 o00 = y00 * c0 - y10 * s0, o10 = y00 * s0 + y10 * c0, o01 = y01 * c1 - y11 * s1, o11 = y01 * s1 + y11 * c1;
                            y00 = o00; y10 = o10; y01 = o01; y11 = o11;
                        }
                        y00 = y00 * osc; y01 = y01 * osc; y10 = y10 * osc; y11 = y11 * osc;
                        bf16_t* dst = isq ? (bf16_t*)(ws + WS_Q) + (size_t)row * DATT + (4 * T + wc) * 64 + 8 * fq
                                          : (bf16_t*)(ws + WS_K) + ((size_t)b * NKEY + s) * DKV + wc * 64 + 8 * fq;
                        u32x4 w0, w1; w0.x = cvt_pk_bf16(y00[0], y00[1]); w0.y = cvt_pk_bf16(y00[2], y00[3]); w0.z = cvt_pk_bf16(y01[0], y01[1]); w0.w = cvt_pk_bf16(y01[2], y01[3]);
                        w1.x = cvt_pk_bf16(y10[0], y10[1]); w1.y = cvt_pk_bf16(y10[2], y10[3]); w1.z = cvt_pk_bf16(y11[0], y11[1]); w1.w = cvt_pk_bf16(y11[2], y11[3]);
                        *(u32x4*)(dst) = w0; *(u32x4*)(dst + 32) = w1; }
            }
        } else {
            const bool isu = T <= 4;
            bf16_t* O = isu ? (bf16_t*)(ws + WS_U) : (bf16_t*)(ws + WS_VV);
            const int colt = 256 * (T - (isu ? 3 : 5)) + wc * 32 + 8 * fq;
            float* vss = (float*)(ws + WS_VSS);
#pragma unroll
            for (int ai = 0; ai < 2; ++ai)
#pragma unroll
                for (int m = 0; m < 4; ++m) { const int row = rbase + ai * 128 + m * 16; float ss = 0.f;
#pragma unroll
                    for (int bj = 0; bj < 2; ++bj) { f32x4 v0 = acc[ai][bj][m][0], v1 = acc[ai][bj][m][1];
#pragma unroll
                        for (int e = 0; e < 4; ++e) { v0[e] = fast_gelu(v0[e]); v1[e] = fast_gelu(v1[e]); ss += v0[e] * v0[e] + v1[e] * v1[e]; }
                        u32x4 w; w.x = cvt_pk_bf16(v0[0], v0[1]); w.y = cvt_pk_bf16(v0[2], v0[3]); w.z = cvt_pk_bf16(v1[0], v1[1]); w.w = cvt_pk_bf16(v1[2], v1[3]);
                        *(u32x4*)(O + (size_t)row * DGM + colt + bj * 128) = w; }
                    if (!isu) { ss += __shfl_xor(ss, 16); ss += __shfl_xor(ss, 32); if (fq == 0) vss[(size_t)row * 8 + (T - 5) * 4 + wc] = ss; } }
        }
    }
};
struct ProbOutProj {
    static constexpr int K = DM; static constexpr bool FP8 = false; static constexpr int SCALE_A = 0, SCALE_B = 0;
    const unsigned char* ws;
    __device__ __forceinline__ const char* a_base(const pg8::Unit& u) const { return (const char*)(ws + WS_MIX) + (size_t)u.pm * 256 * DM * 2; }
    __device__ __forceinline__ const char* b_base(const pg8::Unit& u) const { return (const char*)(ws + WS_WOUT_T) + (size_t)u.pn * 256 * DM * 2; }
    __device__ __forceinline__ unsigned a_offs(const pg8::Unit&, int R, int C) const { return (unsigned)(R * DM + C) * 2u; }
};
struct EpiOutProj {
    static constexpr bool PERM = true;
    bf16_t* proj; const float* mod;
    __device__ __forceinline__ void operator()(const f32x4 (&acc)[2][2][4][2], const pg8::Unit& u, int wr, int wc, int fr, int fq) const {
        const int row0 = u.pm * 256 + wr * 64 + fr, col0 = u.pn * 256 + wc * 32 + 8 * fq;
        const float* gt = mod + (u.pm >> 3) * 6144 + 2048 + col0;
        f32x4 g[2][2];
#pragma unroll
        for (int bj = 0; bj < 2; ++bj)
#pragma unroll
            for (int n = 0; n < 2; ++n) g[bj][n] = *(const f32x4*)(gt + bj * 128 + 4 * n);
#pragma unroll
        for (int ai = 0; ai < 2; ++ai)
#pragma unroll
            for (int m = 0; m < 4; ++m) { bf16_t* rowp = proj + (size_t)(row0 + ai * 128 + m * 16) * DM + col0;
#pragma unroll
                for (int bj = 0; bj < 2; ++bj) { const f32x4 v0 = g[bj][0] * acc[ai][bj][m][0], v1 = g[bj][1] * acc[ai][bj][m][1];
                    u32x4 w; w.x = cvt_pk_bf16(v0[0], v0[1]); w.y = cvt_pk_bf16(v0[2], v0[3]); w.z = cvt_pk_bf16(v1[0], v1[1]); w.w = cvt_pk_bf16(v1[2], v1[3]);
                    *(u32x4*)(rowp + bj * 128) = w; } }
    }
};

#include <hip/hip_bf16.h>
#include <cmath>
namespace attn_body {
using bf16=__hip_bfloat16;
using bf16x8=__attribute__((ext_vector_type(8)))short;
using s16x4=__attribute__((ext_vector_type(4)))short;
using f32x16=__attribute__((ext_vector_type(16)))float;
using u32x4=__attribute__((ext_vector_type(4)))unsigned;
constexpr int D=64,QP=512,KVP=128,OP=1024,SQ=2048,SK=2304;
constexpr int NW=8,QBLK=32,QB=QBLK*NW,KVBLK=64,NQB=SQ/QB;
constexpr int ATTN_UNIT_ROWS=QB;
__device__ __forceinline__ int crow(int r,int hi){return (r&3)+8*(r>>2)+4*hi;}
#define SBAR() __builtin_amdgcn_sched_barrier(0)
__device__ __forceinline__ void cmask(f32x16&p0,f32x16&p1,int jb,int qrel,int hi){
  const float NEG=-INFINITY; int kb=64*jb+4*hi;
  #pragma unroll
  for(int r=0;r<16;++r){int kv=kb+(r&3)+8*(r>>2); if(kv>qrel)p0[r]=NEG; if(kv+32>qrel)p1[r]=NEG;}
}

constexpr int NSLOT=3, SLOTB=8192;
constexpr int LDS_K=0, LDS_V=NSLOT*SLOTB, LDS_WS=2*NSLOT*SLOTB, LDS_OST=LDS_WS+NW*64*4, LDS_BYTES=LDS_OST+NW*4096;
constexpr float C2=0.125f*1.4426950408889634f;
__device__ __forceinline__ void glds16(const void*gsrc,unsigned lds_dst){unsigned keep;
  asm volatile("s_mov_b32 %0, m0\n\ts_mov_b32 m0, %2\n\ts_nop 0\n\tglobal_load_lds_dwordx4 %1, off\n\ts_mov_b32 m0, %0":"=&s"(keep):"v"(gsrc),"s"(lds_dst):"memory");}
__device__ __forceinline__ float max3f(float a,float b,float c){float r;asm("v_max3_f32 %0, %1, %2, %3":"=v"(r):"v"(a),"v"(b),"v"(c));return r;}
__device__ __forceinline__ float max2f(float a,float b){float r;asm("v_max_f32_e32 %0, %1, %2":"=v"(r):"v"(a),"v"(b));return r;}
__device__ __forceinline__ float fadd_s(float a,float b){float r;asm("v_add_f32_e32 %0, %1, %2":"=v"(r):"v"(a),"v"(b));return r;}
__device__ __forceinline__ float fsub_s(float a,float b){float r;asm("v_sub_f32_e32 %0, %1, %2":"=v"(r):"v"(a),"v"(b));return r;}
typedef float f32x2_t __attribute__((ext_vector_type(2))); typedef __bf16 bf16x2_t __attribute__((ext_vector_type(2)));
__device__ __forceinline__ unsigned cvtpk_s(float lo,float hi){f32x2_t v={lo,hi};bf16x2_t b=__builtin_convertvector(v,bf16x2_t);return __builtin_bit_cast(unsigned,b);}
#define WAIT_BAR(N) asm volatile("s_waitcnt vmcnt(" #N ") lgkmcnt(0)\n\ts_barrier":::"memory")

__device__ __forceinline__ void qkt(f32x16&p0,f32x16&p1,const char*Kslot,const bf16x8*qr,const f32x16&negm,int r32,int hi){
  const char*kb=Kslot+hi*1024+r32*16;
  #pragma unroll
  for(int d0=0;d0<4;++d0){
    const bf16x8 b0=*reinterpret_cast<const bf16x8*>(kb+d0*2048);
    const bf16x8 b1=*reinterpret_cast<const bf16x8*>(kb+d0*2048+512);
    if(d0==0){p0=__builtin_amdgcn_mfma_f32_32x32x16_bf16(b0,qr[0],negm,0,0,0);p1=__builtin_amdgcn_mfma_f32_32x32x16_bf16(b1,qr[0],negm,0,0,0);}
    else{p0=__builtin_amdgcn_mfma_f32_32x32x16_bf16(b0,qr[d0],p0,0,0,0);p1=__builtin_amdgcn_mfma_f32_32x32x16_bf16(b1,qr[d0],p1,0,0,0);}}
}
typedef __attribute__((address_space(3))) const char* lds_cptr;
typedef short v4i16_t __attribute__((ext_vector_type(4)));
__device__ __forceinline__ void kload8(bf16x8*kf,lds_cptr kp){
  kf[0]=*(const __attribute__((address_space(3))) bf16x8*)(kp);      kf[1]=*(const __attribute__((address_space(3))) bf16x8*)(kp+512);
  kf[2]=*(const __attribute__((address_space(3))) bf16x8*)(kp+2048); kf[3]=*(const __attribute__((address_space(3))) bf16x8*)(kp+2560);
  kf[4]=*(const __attribute__((address_space(3))) bf16x8*)(kp+4096); kf[5]=*(const __attribute__((address_space(3))) bf16x8*)(kp+4608);
  kf[6]=*(const __attribute__((address_space(3))) bf16x8*)(kp+6144); kf[7]=*(const __attribute__((address_space(3))) bf16x8*)(kp+6656);
}
__device__ __forceinline__ void kload2(bf16x8*kf,lds_cptr kp,int j){ kf[2*j]=*(const __attribute__((address_space(3))) bf16x8*)(kp+j*2048); kf[2*j+1]=*(const __attribute__((address_space(3))) bf16x8*)(kp+j*2048+512); }
__device__ __forceinline__ s16x4 vtr(lds_cptr p){ return __builtin_bit_cast(s16x4,__builtin_amdgcn_ds_read_tr16_b64_v4i16((__attribute__((address_space(3))) v4i16_t*)p)); }
__device__ __forceinline__ float rowmax(const f32x16&p0,const f32x16&p1){
  float a=max3f(p0[0],p0[1],p1[0]),b=max3f(p0[2],p0[3],p1[1]);a=max3f(a,p1[2],p1[3]);
  #pragma unroll
  for(int r=4;r<16;r+=4){a=max3f(a,p0[r],p0[r+1]);b=max3f(b,p0[r+2],p0[r+3]);a=max3f(a,p1[r],p1[r+1]);b=max3f(b,p1[r+2],p1[r+3]);}
  const float m=max2f(a,b);
  auto rr=__builtin_amdgcn_permlane32_swap(__float_as_uint(m),__float_as_uint(m),false,false);
  return max2f(__uint_as_float(rr[0]),__uint_as_float(rr[1]));
}
__device__ __forceinline__ void pv(f32x16*o,int vb,bf16x8 pa0,bf16x8 pa1,bf16x8 pa2,bf16x8 pa3){
  #pragma unroll
  for(int d0=0;d0<2;++d0){s16x4 lo[4],hi[4];
    #pragma unroll
    for(int ks=0;ks<4;++ks){
      asm volatile("ds_read_b64_tr_b16 %0,%1 offset:%c2":"=&v"(lo[ks]):"v"(vb),"i"(d0*4096+ks*1024):"memory");
      asm volatile("ds_read_b64_tr_b16 %0,%1 offset:%c2":"=&v"(hi[ks]):"v"(vb),"i"(d0*4096+ks*1024+512):"memory");}
    asm volatile("s_waitcnt lgkmcnt(0)":::"memory");SBAR();
    #define PK(k) (bf16x8){lo[k][0],lo[k][1],lo[k][2],lo[k][3],hi[k][0],hi[k][1],hi[k][2],hi[k][3]}
    o[d0]=__builtin_amdgcn_mfma_f32_32x32x16_bf16(pa0,PK(0),o[d0],0,0,0);
    o[d0]=__builtin_amdgcn_mfma_f32_32x32x16_bf16(pa1,PK(1),o[d0],0,0,0);
    o[d0]=__builtin_amdgcn_mfma_f32_32x32x16_bf16(pa2,PK(2),o[d0],0,0,0);
    o[d0]=__builtin_amdgcn_mfma_f32_32x32x16_bf16(pa3,PK(3),o[d0],0,0,0);
    #undef PK
  }
}

#ifndef ATTN_STORE16
#define ATTN_STORE16(p,v) (*(u32x4*)(p)=(v))
#endif
template<int THRL> __device__ __forceinline__ void attn_unit(int b,int h,int qb,const bf16*Q,const bf16*__restrict__ K,const bf16*__restrict__ V,bf16*O,char*shm){
  const int tid=threadIdx.x,lane=tid&63,r32=lane&31,hi=lane>>5; const int wid=__builtin_amdgcn_readfirstlane(tid>>6);
  const long rowbase=(long)b*SQ; const int q0=qb*QB; const int kvh=h>>2;
  const bf16*Qw=Q+(rowbase+q0+wid*QBLK)*QP+h*D;
  const bf16*Kh=K+(long)b*SK*KVP+kvh*D,*Vh=V+(long)b*SK*KVP+kvh*D;
  const unsigned lds0=(unsigned)(uintptr_t)shm;
  float*wsf=(float*)(shm+LDS_WS)+wid*64;
  const bf16*ksrc=Kh+(long)lane*KVP+wid*8;
  const bf16*vsrc=Vh+(long)(16*(wid&3)+(lane>>2))*KVP+(wid>>2)*32+(lane&3)*8;
  const unsigned kdst=lds0+LDS_K+wid*1024, vdst=lds0+LDS_V+wid*1024;
  #define DMA_K(t,slot) glds16(ksrc+(long)(t)*KVBLK*KVP,(unsigned)__builtin_amdgcn_readfirstlane(kdst+(slot)))
  #define DMA_V(t,slot) glds16(vsrc+(long)(t)*KVBLK*KVP,(unsigned)__builtin_amdgcn_readfirstlane(vdst+(slot)))
  const int vb0=(int)(lds0+LDS_V)+((lane>>4)&1)*32+(lane&3)*8+(4*hi+((lane&15)>>2))*64;
  const char*Kbase=shm+LDS_K; bf16x8 kf[8];
  const lds_cptr shm3=(lds_cptr)shm; const lds_cptr kp0=shm3+LDS_K+hi*1024+r32*16; const lds_cptr vp0=shm3+LDS_V+((lane>>4)&1)*32+(lane&3)*8+(4*hi+((lane&15)>>2))*64;
  constexpr int NT=SK/KVBLK;
  DMA_K(0,0);DMA_V(0,0);DMA_K(1,SLOTB);
  bf16x8 qr[4];
  #pragma unroll
  for(int d0=0;d0<4;++d0)qr[d0]=*reinterpret_cast<const bf16x8*>(&Qw[(long)r32*QP+d0*16+hi*8]);
  float mhat=0.f,l_reg=0.f;f32x16 o[2];o[0]=f32x16{};o[1]=f32x16{};f32x16 negm=f32x16{};asm volatile("":"+v"(negm));
  #define CMASK(P0,P1,t) do{}while(0)
  bool resc=false;
  #define START(P0,P1) do{ const float rm=rowmax(P0,P1); resc=false; \
    { const float dl=rm; mhat=fadd_s(mhat,dl); \
      _Pragma("unroll") for(int r=0;r<16;++r){P0[r]=fsub_s(P0[r],dl);P1[r]=fsub_s(P1[r],dl);} \
      _Pragma("unroll") for(int r=0;r<16;++r)negm[r]=-mhat; asm volatile("":"+v"(negm)); } \
    _Pragma("unroll") for(int r=0;r<16;++r)P0[r]=__builtin_amdgcn_exp2f(P0[r]); }while(0)
  #define RESC() do{ if(resc){ asm volatile("s_waitcnt lgkmcnt(0)":::"memory"); \
      _Pragma("unroll") for(int d_=0;d_<2;++d_) _Pragma("unroll") for(int r=0;r<16;++r)o[d_][r]*=wsf[crow(r,hi)]; } }while(0)
  f32x16 pA0,pA1,pB0,pB1;
  int sl_prev=0,sl_cur=0,sl_next=SLOTB;
  #define ROT() do{sl_prev=sl_cur;sl_cur=sl_next;sl_next=(sl_next==(NSLOT-1)*SLOTB)?0:sl_next+SLOTB;}while(0)
  DMA_K(2,2*SLOTB);
  WAIT_BAR(3);
  qkt(pA0,pA1,Kbase,qr,negm,r32,hi);asm volatile("s_nop 15\n\ts_nop 7":"+v"(pA0),"+v"(pA1));CMASK(pA0,pA1,0);
  START(pA0,pA1);
  _Pragma("unroll") for(int r=0;r<16;++r)pA1[r]=__builtin_amdgcn_exp2f(pA1[r]);
  WAIT_BAR(0);
  DMA_K(3,0);DMA_V(1,SLOTB);
  ROT();
  kload8(kf,kp0+sl_cur);
  WAIT_BAR(2);
  s16x4 vlo[8],vhi[8]; u32x4 pw0,pw1,pw2,pw3;
  #define PKW(P,B) cvtpk_s(P[B],P[B+1])
  #define PAF(k) __builtin_bit_cast(bf16x8,pw##k)
  #define VFR(i) (bf16x8){vlo[i][0],vlo[i][1],vlo[i][2],vlo[i][3],vhi[i][0],vhi[i][1],vhi[i][2],vhi[i][3]}
  #define PIN(x) asm volatile("":"+v"(x))
  #define MX3(a,b,c) __builtin_fmaxf(__builtin_fmaxf((a),(b)),(c))
  #define GAPA(MF,A0,A1,A2,A3,W0,W1,PW) do{ MF; sacc+=A0; sacc+=A1; sacc+=A2; sacc+=A3; PIN(sacc); W0; W1; PIN(PW); SBAR(); }while(0)
  #define EX(v) __builtin_amdgcn_exp2f(v)
  #define GAPB(MF,X,B) do{ MF; X[B]=EX(X[B]); X[B+1]=EX(X[B+1]); X[B+2]=EX(X[B+2]); X[B+3]=EX(X[B+3]); PIN(X); SBAR(); }while(0)
  #define VRD(i) do{ vlo[i]=vtr(vp_+(((i)>>2)*4096+((i)&3)*1024)); vhi[i]=vtr(vp_+(((i)>>2)*4096+((i)&3)*1024+512)); }while(0)
  #define KRD(G,j) do{ if(G){ kload2(kf,kp0+sl_next,j); SBAR(); } }while(0)
  #define STEP(C0,C1,P0,P1,t,GK,GV,GL) do{ SBAR(); \
    const lds_cptr vp_=vp0+sl_prev; \
    VRD(0); SBAR(); float sacc=(P0[0]+P0[1]); \
    GAPA(C0=__builtin_amdgcn_mfma_f32_32x32x16_bf16(kf[0],qr[0],negm,0,0,0), P0[2],P0[3],P0[4],P0[5],     pw0[0]=PKW(P0,0), pw0[1]=PKW(P0,2), pw0); \
    VRD(4); SBAR(); GAPA(C1=__builtin_amdgcn_mfma_f32_32x32x16_bf16(kf[1],qr[0],negm,0,0,0), P0[6],P0[7],P0[8],P0[9],     pw0[2]=PKW(P0,4), pw0[3]=PKW(P0,6), pw0); \
    VRD(1); SBAR(); GAPA(C0=__builtin_amdgcn_mfma_f32_32x32x16_bf16(kf[2],qr[1],C0,0,0,0),   P0[10],P0[11],P0[12],P0[13], pw1[0]=PKW(P0,8), pw1[1]=PKW(P0,10), pw1); \
    VRD(5); SBAR(); GAPA(C1=__builtin_amdgcn_mfma_f32_32x32x16_bf16(kf[3],qr[1],C1,0,0,0),   P0[14],P0[15],P1[0],P1[1],   pw1[2]=PKW(P0,12),pw1[3]=PKW(P0,14), pw1); \
    VRD(2); SBAR(); GAPA(C0=__builtin_amdgcn_mfma_f32_32x32x16_bf16(kf[4],qr[2],C0,0,0,0),   P1[2],P1[3],P1[4],P1[5],     pw2[0]=PKW(P1,0), pw2[1]=PKW(P1,2), pw2); \
    VRD(6); SBAR(); GAPA(C1=__builtin_amdgcn_mfma_f32_32x32x16_bf16(kf[5],qr[2],C1,0,0,0),   P1[6],P1[7],P1[8],P1[9],     pw2[2]=PKW(P1,4), pw2[3]=PKW(P1,6), pw2); \
    VRD(3); SBAR(); GAPA(C0=__builtin_amdgcn_mfma_f32_32x32x16_bf16(kf[6],qr[3],C0,0,0,0),   P1[10],P1[11],P1[12],P1[13], pw3[0]=PKW(P1,8), pw3[1]=PKW(P1,10), pw3); \
    VRD(7); SBAR(); GAPA(C1=__builtin_amdgcn_mfma_f32_32x32x16_bf16(kf[7],qr[3],C1,0,0,0),   P1[14],P1[15],0.f,0.f,       pw3[2]=PKW(P1,12),pw3[3]=PKW(P1,14), pw3); \
    l_reg+=sacc; \
    if(GK){DMA_K((t)+3,sl_cur);} if(GV){DMA_V((t)+1,sl_next);} \
    CMASK(C0,C1,t); \
    { float a=MX3(C0[0],C0[1],C1[0]),b=MX3(C0[2],C0[3],C1[1]); a=MX3(a,C1[2],C1[3]); \
      _Pragma("unroll") for(int r=4;r<16;r+=4){a=MX3(a,C0[r],C0[r+1]);b=MX3(b,C0[r+2],C0[r+3]);a=MX3(a,C1[r],C1[r+1]);b=MX3(b,C1[r+2],C1[r+3]);} \
      float rm=__builtin_fmaxf(a,b); { auto rr=__builtin_amdgcn_permlane32_swap(__float_as_uint(rm),__float_as_uint(rm),false,false); rm=__builtin_fmaxf(__uint_as_float(rr[0]),__uint_as_float(rr[1])); } \
      resc=false; \
      if(__builtin_expect(__any(rm>(float)THRL),0)){ const float dl=__builtin_fmaxf(rm,0.f); mhat+=dl; \
        _Pragma("unroll") for(int r=0;r<16;++r){C0[r]-=dl;C1[r]-=dl;} \
        _Pragma("unroll") for(int r=0;r<16;++r)negm[r]=-mhat; asm volatile("":"+v"(negm)); \
        const float f=__builtin_amdgcn_exp2f(-dl); l_reg*=f; if(hi==0)wsf[r32]=f; resc=true; } } \
    SBAR(); \
    GAPB(o[0]=__builtin_amdgcn_mfma_f32_32x32x16_bf16(PAF(0),VFR(0),o[0],0,0,0), C0,0); \
    GAPB(o[1]=__builtin_amdgcn_mfma_f32_32x32x16_bf16(PAF(0),VFR(4),o[1],0,0,0), C0,4); \
    KRD(GL,0); GAPB(o[0]=__builtin_amdgcn_mfma_f32_32x32x16_bf16(PAF(1),VFR(1),o[0],0,0,0), C0,8); \
    KRD(GL,1); GAPB(o[1]=__builtin_amdgcn_mfma_f32_32x32x16_bf16(PAF(1),VFR(5),o[1],0,0,0), C0,12); \
    KRD(GL,2); GAPB(o[0]=__builtin_amdgcn_mfma_f32_32x32x16_bf16(PAF(2),VFR(2),o[0],0,0,0), C1,0); \
    KRD(GL,3); GAPB(o[1]=__builtin_amdgcn_mfma_f32_32x32x16_bf16(PAF(2),VFR(6),o[1],0,0,0), C1,4); \
    GAPB(o[0]=__builtin_amdgcn_mfma_f32_32x32x16_bf16(PAF(3),VFR(3),o[0],0,0,0), C1,8); \
    GAPB(o[1]=__builtin_amdgcn_mfma_f32_32x32x16_bf16(PAF(3),VFR(7),o[1],0,0,0), C1,12); \
    }while(0)
  int t=1;
  #undef CMASK
  #define CMASK(P0,P1,t) do{}while(0)
  for(;t+5<NT;t+=2){
    STEP(pB0,pB1,pA0,pA1,t,true,true,true);     WAIT_BAR(2); RESC(); ROT();
    STEP(pA0,pA1,pB0,pB1,t+1,true,true,true);   WAIT_BAR(2); RESC(); ROT();
  }
  #undef CMASK
  #define CMASK(P0,P1,t) do{}while(0)
  #define ENDW(tt) do{ if((tt)+3<NT){WAIT_BAR(2);} else if((tt)+2<NT){WAIT_BAR(1);} else {WAIT_BAR(0);} }while(0)
  for(;t+1<NT;t+=2){
    STEP(pB0,pB1,pA0,pA1,t,(t+3<NT),(t+1<NT),(t+1<NT));       ENDW(t);   RESC(); ROT();
    STEP(pA0,pA1,pB0,pB1,t+1,(t+4<NT),(t+2<NT),(t+2<NT));     ENDW(t+1); RESC(); ROT();
  }
  STEP(pB0,pB1,pA0,pA1,NT-1,false,false,false); RESC();
  { float sacc=pB0[0]+pB0[1]; _Pragma("unroll") for(int r=2;r<16;++r)sacc+=pB0[r]; _Pragma("unroll") for(int r=0;r<16;++r)sacc+=pB1[r]; l_reg+=sacc;
    pw0=(u32x4){PKW(pB0,0),PKW(pB0,2),PKW(pB0,4),PKW(pB0,6)};pw1=(u32x4){PKW(pB0,8),PKW(pB0,10),PKW(pB0,12),PKW(pB0,14)};pw2=(u32x4){PKW(pB1,0),PKW(pB1,2),PKW(pB1,4),PKW(pB1,6)};pw3=(u32x4){PKW(pB1,8),PKW(pB1,10),PKW(pB1,12),PKW(pB1,14)};
    SBAR(); pv(o,vb0+sl_cur,PAF(0),PAF(1),PAF(2),PAF(3)); }
  #undef PKW
  #undef PAF
  #undef VFR
  #undef PIN
  #undef MX3
  #undef GAPA
  #undef GAPB
  #undef EX
  #undef VRD
  #undef KRD
  #undef STEP
  #undef ENDW
  {auto rr=__builtin_amdgcn_permlane32_swap(__float_as_uint(l_reg),__float_as_uint(l_reg),false,false);l_reg=__uint_as_float(rr[0])+__uint_as_float(rr[1]);}
  if(hi==0)wsf[32+r32]=l_reg;asm volatile("s_waitcnt lgkmcnt(0)":::"memory");
  float rli[16];
  #pragma unroll
  for(int r=0;r<16;++r)rli[r]=__builtin_amdgcn_rcpf(wsf[32+crow(r,hi)]);
  bf16*Ow=O+(rowbase+q0+wid*QBLK)*OP+h*D;
  { bf16*stg=(bf16*)(shm+LDS_OST)+wid*2048;
    #pragma unroll
    for(int r=0;r<16;++r){const int orow=crow(r,hi);
      #pragma unroll
      for(int d0=0;d0<2;++d0)stg[orow*64+d0*32+r32]=__float2bfloat16(o[d0][r]*rli[r]);}
    asm volatile("s_waitcnt lgkmcnt(0)":::"memory");
    #pragma unroll
    for(int i=0;i<4;++i){const int row=i*8+(lane>>3),ch=lane&7; const u32x4 v=*(const u32x4*)(stg+row*64+ch*8); ATTN_STORE16(Ow+(long)row*OP+ch*8,v);} }
  asm volatile("s_waitcnt lgkmcnt(0)\n\ts_barrier":::"memory");
  #undef DMA_K
  #undef DMA_V
  #undef CMASK
  #undef START
  #undef RESC
  #undef ROT
}
constexpr int ATTN_LDS_BYTES=LDS_BYTES;
template<int THRL> __device__ __forceinline__ void attn_unit_L(int L,char*lds,const bf16*Q,const bf16*K,const bf16*V,bf16*O){
  const int xg=(L&255)>>5, rd=L>>8, pair=(4*xg+rd)&31, w=L&31, b=pair>>1, kvh=pair&1, g=w>>3, qb=w&7;
  attn_unit<THRL>(b,kvh*4+g,qb,Q,K,V,O,lds);
}
#undef SBAR
#undef WAIT_BAR
}

typedef GAS unsigned gu32;
typedef GAS unsigned long long gu64;
#define RLX_AGENT __ATOMIC_RELAXED, __HIP_MEMORY_SCOPE_AGENT

#define XB_TMO      128
#define XB_XCNT(j)  (256  + 64 * (j))
#define XB_XSUB(j)  (1280 + 64 * (j))
#define XB_XGEN(j)  (2304 + 64 * (j))
#define XB_TOP      3328
#define XB_TOPGEN   3392
#define XCD_BAR_WORDS 3456
#define XB_SPIN_CAP (1u << 18)

__device__ __forceinline__ unsigned xb_ld(unsigned* p)              { return __hip_atomic_load(p, __ATOMIC_RELAXED, __HIP_MEMORY_SCOPE_AGENT); }
__device__ __forceinline__ unsigned xb_add(unsigned* p, unsigned v) { return __hip_atomic_fetch_add(p, v, __ATOMIC_RELAXED, __HIP_MEMORY_SCOPE_AGENT); }
__device__ __forceinline__ unsigned xb_xcc_id() { return (unsigned)__builtin_amdgcn_s_getreg((3 << 11) | 20) & 0xFu; }
#define XB_SPIN(cond, bar) do { unsigned _sp = 0; while (cond) { __builtin_amdgcn_s_sleep(1); \
    if ((++_sp & 255u) == 0u) { if (xb_ld(&(bar)[XB_TMO])) break; if (_sp > XB_SPIN_CAP) { atomicAdd(&(bar)[XB_TMO], 1u); break; } } } } while (0)

struct XcdBarrier {
    unsigned* bar; unsigned x;
    volatile LAS unsigned* st;
};

__device__ __forceinline__ XcdBarrier xcd_barrier_post(unsigned* bar, volatile LAS unsigned* st) {
    XcdBarrier b; b.bar = bar; b.x = xb_xcc_id(); b.st = st;
    if (threadIdx.x == 0) (void)xb_add(&bar[XB_XCNT(b.x)], 1u);
    return b;
}
__device__ __forceinline__ void xcd_barrier_complete(unsigned* bar, unsigned x, unsigned& nloc, unsigned& nx) {
    const unsigned G = gridDim.x * gridDim.y * gridDim.z;
    unsigned sum, cnt, mine, sp = 0u;
    for (;;) {
        sum = 0u; cnt = 0u; mine = 0u;
#pragma unroll
        for (unsigned j = 0; j < 16; ++j) { const unsigned c = xb_ld(&bar[XB_XCNT(j)]); sum += c; cnt += (c > 0u) ? 1u : 0u; mine = (j == x) ? c : mine; }
        if (sum == G) break;
        __builtin_amdgcn_s_sleep(1);
        if ((++sp & 255u) == 0u) { if (xb_ld(&bar[XB_TMO])) break; if (sp > XB_SPIN_CAP) { atomicAdd(&bar[XB_TMO], 1u); break; } }
    }
    nloc = mine > 0u ? mine : 1u; nx = cnt > 0u ? cnt : 1u;
}

__device__ __forceinline__ void xcd_barrier(const XcdBarrier& b) {
    asm volatile("s_waitcnt vmcnt(0)" ::: "memory");
    __syncthreads();
    if (threadIdx.x == 0) {
        unsigned* bar = b.bar;
        __builtin_amdgcn_s_waitcnt(0);
        unsigned nloc = b.st[0], nx = b.st[1];
        if (nloc == 0u) { xcd_barrier_complete(bar, b.x, nloc, nx); b.st[0] = nloc; b.st[1] = nx; }
        const unsigned old = xb_add(&bar[XB_XSUB(b.x)], 1u);
        const unsigned gen = old / nloc;
        if (old + 1u == (gen + 1u) * nloc) {
            __builtin_amdgcn_fence(__ATOMIC_RELEASE, "agent");
            asm volatile("s_waitcnt vmcnt(0)" ::: "memory");
            const unsigned og = xb_add(&bar[XB_TOP], 1u);
            const unsigned tg = og / nx;
            if (og + 1u == (tg + 1u) * nx) xb_add(&bar[XB_TOPGEN], 1u);
            else XB_SPIN(xb_ld(&bar[XB_TOPGEN]) == tg, bar);
            __builtin_amdgcn_fence(__ATOMIC_ACQUIRE, "agent");
            xb_add(&bar[XB_XGEN(b.x)], 1u);
            asm volatile("s_waitcnt vmcnt(0)" ::: "memory");
        } else {
            XB_SPIN(xb_ld(&bar[XB_XGEN(b.x)]) == gen, bar);
            __builtin_amdgcn_fence(__ATOMIC_ACQUIRE, "agent");
            asm volatile("s_waitcnt vmcnt(0)" ::: "memory");
        }
    }
    __syncthreads();
}

constexpr int NWAVES = 8, NTHREADS = NWAVES * 64;
constexpr int LDS_BYTES = 160 * 1024;
#define LDS_WAIT() asm volatile("s_waitcnt lgkmcnt(0)" ::: "memory")
#define VM_WAIT() asm volatile("s_waitcnt vmcnt(0)" ::: "memory")

struct Frame {
    LAS unsigned char* lds;
    int tid, lane, wave, G, bx;
    Params p;
};

__device__ __forceinline__ void p0_adaln(Frame& F) {
    LAS float* st = (LAS float*)F.lds;
    LAS float* red = (LAS float*)(F.lds + 1024 * 20 * 4);
    const Params& p = F.p;
    for (int k = F.tid; k < DM; k += NTHREADS) {
#pragma unroll
        for (int r = 0; r < 17; ++r) { const float c = (r < 16) ? p.c[r * DM + k] : p.c_ctx[k]; st[k * 20 + r] = silu_f(c); }
    }
    __syncthreads();
    const int col = F.lane & 15, kq = F.lane >> 4;
    for (int item = F.bx; item < 6144 / 16; item += F.G) {
        const int n0 = item * 16;
        float acc[17];
#pragma unroll
        for (int r = 0; r < 17; ++r) acc[r] = 0.f;
        const float* wp = p.w_mod + (size_t)(F.wave * 128 + kq) * 6144 + n0 + col;
#pragma unroll 8
        for (int it = 0; it < 32; ++it) {
            const float w = __builtin_nontemporal_load(wp + (size_t)it * 4 * 6144);
            const LAS float* sr = st + (F.wave * 128 + it * 4 + kq) * 20;
            const f32x4 s0 = *(const LAS f32x4*)(sr), s1 = *(const LAS f32x4*)(sr + 4), s2 = *(const LAS f32x4*)(sr + 8), s3 = *(const LAS f32x4*)(sr + 12); const float s4 = sr[16];
            acc[0] += s0[0] * w; acc[1] += s0[1] * w; acc[2] += s0[2] * w; acc[3] += s0[3] * w;
            acc[4] += s1[0] * w; acc[5] += s1[1] * w; acc[6] += s1[2] * w; acc[7] += s1[3] * w;
            acc[8] += s2[0] * w; acc[9] += s2[1] * w; acc[10] += s2[2] * w; acc[11] += s2[3] * w;
            acc[12] += s3[0] * w; acc[13] += s3[1] * w; acc[14] += s3[2] * w; acc[15] += s3[3] * w; acc[16] += s4 * w;
        }
#pragma unroll
        for (int r = 0; r < 17; ++r) { acc[r] += __shfl_xor(acc[r], 16); acc[r] += __shfl_xor(acc[r], 32); }
        if (kq == 0) {
#pragma unroll
            for (int r = 0; r < 17; ++r) red[(F.wave * 17 + r) * 16 + col] = acc[r];
        }
        __syncthreads();
        if (F.tid < 17 * 16) { const int r = F.tid >> 4, c = F.tid & 15; float s = 0.f;
#pragma unroll
            for (int w = 0; w < 8; ++w) s += red[(w * 17 + r) * 16 + c];
            ((float*)(p.ws + WS_MOD))[r * 6144 + n0 + c] = s + p.b_mod[n0 + c]; }
        __syncthreads();
    }
}
__device__ __forceinline__ void p0_transpose_item(const float* W, int N, bf16_t* WT, int K, int k0, int n0, int row_t0, LAS float* scr, int lane) {
    const float* src = W + (size_t)(k0 + (lane >> 5)) * N + n0 + (lane & 31);
    float v[32];
#pragma unroll
    for (int i = 0; i < 32; ++i) v[i] = __builtin_nontemporal_load(src + (size_t)(2 * i) * N);
#pragma unroll
    for (int i = 0; i < 32; ++i) scr[(2 * i + (lane >> 5)) * 33 + (lane & 31)] = v[i];
    LDS_WAIT(); asm volatile("" ::: "memory");
    const int c = lane & 7;
#pragma unroll
    for (int j = 0; j < 4; ++j) { const int n = (lane >> 3) + 8 * j; const LAS float* s = scr + (8 * c) * 33 + n;
        u32x4 o; o.x = cvt_pk_bf16(s[0 * 33], s[1 * 33]); o.y = cvt_pk_bf16(s[2 * 33], s[3 * 33]); o.z = cvt_pk_bf16(s[4 * 33], s[5 * 33]); o.w = cvt_pk_bf16(s[6 * 33], s[7 * 33]);
        *(u32x4*)(WT + (size_t)(row_t0 + n) * K + k0 + 8 * c) = o; }
    LDS_WAIT(); asm volatile("" ::: "memory");
}
__device__ __forceinline__ void p0_transpose_item_fp8(const float* W, int N, unsigned char* WT, int K, int k0, int n0, int row_t0, LAS float* scr, int lane) {
    const float* src = W + (size_t)(k0 + (lane >> 5)) * N + n0 + (lane & 31);
    float v[64];
#pragma unroll
    for (int i = 0; i < 64; ++i) v[i] = __builtin_nontemporal_load(src + (size_t)(2 * i) * N);
#pragma unroll
    for (int i = 0; i < 64; ++i) scr[(2 * i + (lane >> 5)) * 33 + (lane & 31)] = v[i];
    LDS_WAIT(); asm volatile("" ::: "memory");
    const int c = lane & 7;
#pragma unroll
    for (int j = 0; j < 4; ++j) { const int n = (lane >> 3) + 8 * j; const LAS float* s = scr + (16 * c) * 33 + n;
        u32x4 o;
        o.x = pk4_fp8(s[0 * 33], s[1 * 33], s[2 * 33], s[3 * 33], W8_SCALE); o.y = pk4_fp8(s[4 * 33], s[5 * 33], s[6 * 33], s[7 * 33], W8_SCALE);
        o.z = pk4_fp8(s[8 * 33], s[9 * 33], s[10 * 33], s[11 * 33], W8_SCALE); o.w = pk4_fp8(s[12 * 33], s[13 * 33], s[14 * 33], s[15 * 33], W8_SCALE);
        __builtin_nontemporal_store(o, (u32x4*)(WT + (size_t)(row_t0 + n) * K + k0 + 16 * c)); }
    LDS_WAIT(); asm volatile("" ::: "memory");
}
__device__ __forceinline__ void convert_experts(Frame& F, int lo, int hi, int worker, int nworkers) {
    const Params& p = F.p;
    __syncthreads();
    LAS float* scr = (LAS float*)(F.lds + F.wave * 16896);
    constexpr int I_E = (DM / 128) * (FF / 32);
    unsigned char* w13_t = p.ws + WS_W13_T; unsigned char* w2_t = p.ws + WS_W2_T;
    for (int it = lo + worker; it < hi; it += nworkers) {
        int r = it;
        const int e = r / (3 * I_E); r -= e * 3 * I_E; const int which = r / I_E; r -= which * I_E;
        if (which < 2) { const int nblk = FF / 32, kb = r / nblk, nb = r % nblk, n0 = nb * 32, rt = 256 * (n0 >> 7) + 128 * which + (n0 & 127);
            p0_transpose_item_fp8((which ? p.w3 : p.w1) + (size_t)e * DM * FF, FF, w13_t + (size_t)e * 2 * FF * DM, DM, kb * 128, n0, rt, scr, F.lane); }
        else { const int nblk = DM / 32, kb = r / nblk, nb = r % nblk;
            p0_transpose_item_fp8(p.w2 + (size_t)e * FF * DM, DM, w2_t + (size_t)e * DM * FF, FF, kb * 128, nb * 32, nb * 32, scr, F.lane); }
    }
    __syncthreads();
}
constexpr int CONV_NIT = NE * 3 * (DM / 128) * (FF / 32);
constexpr int CONV_EARLY = 5376;
__device__ __forceinline__ void p0_convert(Frame& F) {
    const Params& p = F.p;
    __syncthreads();
    LAS float* scr = (LAS float*)(F.lds + F.wave * 16896);
    const int gw = F.bx * NWAVES + F.wave, NGW = F.G * NWAVES;
    constexpr int I_IN = (DM / 64) * (DIN / 32), I_OUT = (DM / 64) * (DM / 32);
    bf16_t* win_t = (bf16_t*)(p.ws + WS_WIN_T); bf16_t* wout_t = (bf16_t*)(p.ws + WS_WOUT_T);
    for (int it = gw; it < I_IN + I_OUT; it += NGW) {
        int r = it;
        if (r < I_IN) { const int nblk = DIN / 32, kb = r / nblk, nb = r % nblk, n0 = nb * 32, T = n0 >> 8; int rt = n0;
            if (T < 3) { const int loc = n0 & 255, wc = loc >> 6, bj = (loc >> 5) & 1; rt = 256 * T + 128 * bj + 32 * wc; }
            p0_transpose_item(p.w_in, DIN, win_t, DM, kb * 64, n0, rt, scr, F.lane); continue; }
        r -= I_IN;
        { const int nblk = DM / 32, kb = r / nblk, nb = r % nblk; p0_transpose_item(p.w_out, DM, wout_t, DM, kb * 64, nb * 32, nb * 32, scr, F.lane); }
    }
    const int gt = F.bx * NTHREADS + F.tid, NGT = F.G * NTHREADS;
    for (int i = gt; i < NGRP * CHUNK * CHUNK / 2; i += NGT) { const f32x2 v = *(const f32x2*)(p.w_s + 2 * i); ((unsigned*)(p.ws + WS_WS_B))[i] = cvt_pk_bf16(v[0], v[1]); }
    for (int idx = gt; idx < 2048 * 32; idx += NGT) {
        const int t = idx >> 5, i = idx & 31, f = i & 15;
        const float inv = exp2f(-(float)f * (13.287712379549449f / 16.f));
        const float pos = (i < 16) ? (float)(t >> 6) : (float)(t & 63);
        const float ang = pos * inv;
        float* cs = (float*)(p.ws + WS_ROPE);
        cs[idx] = cosf(ang); cs[2048 * 32 + idx] = sinf(ang);
    }
}
template <int CTRL> __device__ __forceinline__ float dpp_mov(float v) { return __uint_as_float((unsigned)__builtin_amdgcn_mov_dpp((int)__float_as_uint(v), CTRL, 0xF, 0xF, true)); }
constexpr int DPP_XOR1 = 0xB1  , DPP_XOR2 = 0x4E  , DPP_HMIRROR = 0x141  , DPP_MIRROR = 0x140  ;
__device__ __forceinline__ float swap16_sum(float x, float y) { auto rr = __builtin_amdgcn_permlane16_swap(__float_as_uint(x), __float_as_uint(y), false, false); return __uint_as_float(rr[0]) + __uint_as_float(rr[1]); }
__device__ __forceinline__ float swap32_sum(float x, float y) { auto rr = __builtin_amdgcn_permlane32_swap(__float_as_uint(x), __float_as_uint(y), false, false); return __uint_as_float(rr[0]) + __uint_as_float(rr[1]); }
__device__ __forceinline__ float swap16_max(float x) { auto rr = __builtin_amdgcn_permlane16_swap(__float_as_uint(x), __float_as_uint(x), false, false); return fmaxf(__uint_as_float(rr[0]), __uint_as_float(rr[1])); }
__device__ __forceinline__ float swap32_max(float x) { auto rr = __builtin_amdgcn_permlane32_swap(__float_as_uint(x), __float_as_uint(x), false, false); return fmaxf(__uint_as_float(rr[0]), __uint_as_float(rr[1])); }
__device__ __forceinline__ float wave_sum(float v) {
    v += dpp_mov<DPP_XOR1>(v); v += dpp_mov<DPP_XOR2>(v); v += dpp_mov<DPP_HMIRROR>(v); v += dpp_mov<DPP_MIRROR>(v);
    v = swap16_sum(v, v); return swap32_sum(v, v);
}
__device__ __forceinline__ void p1_modulate(Frame& F) {
    const Params& p = F.p;
    const int gw = F.bx * NWAVES + F.wave, NGW = F.G * NWAVES;
    const float* modb = (const float*)(p.ws + WS_MOD);
    for (int pr = gw; pr < MALL / 4; pr += NGW) {
        const int row0 = 4 * pr;
        const float* xr; const float* mod;
        if (row0 < MLAT) { xr = p.x + (size_t)row0 * DM; mod = modb + (row0 >> 11) * 6144; } else { xr = p.ctx + (size_t)(row0 - MLAT) * DM; mod = modb + 16 * 6144; }
        f32x4 v[4][4];
#pragma unroll
        for (int r = 0; r < 4; ++r)
#pragma unroll
            for (int j = 0; j < 4; ++j) v[r][j] = __builtin_nontemporal_load((const f32x4*)(xr + (size_t)r * DM + 4 * F.lane + 256 * j));
        f32x4 gs[4], sh[4];
#pragma unroll
        for (int j = 0; j < 4; ++j) { const int k = 4 * F.lane + 256 * j; gs[j] = *(const f32x4*)(p.g_mix + k) * (*(const f32x4*)(mod + 1024 + k) + 1.f); sh[j] = *(const f32x4*)(mod + k); }
#pragma unroll
        for (int r = 0; r < 4; ++r) { float ss = 0.f;
#pragma unroll
            for (int j = 0; j < 4; ++j) ss += (v[r][j][0] * v[r][j][0] + v[r][j][1] * v[r][j][1]) + (v[r][j][2] * v[r][j][2] + v[r][j][3] * v[r][j][3]);
            const float rstd = rsqrtf(wave_sum(ss) * (1.f / DM) + EPS);
            bf16_t* o = (bf16_t*)(p.ws + WS_XN) + (size_t)(row0 + r) * DM;
#pragma unroll
            for (int j = 0; j < 4; ++j) { const f32x4 h = v[r][j] * rstd * gs[j] + sh[j];
                u32x2 w; w.x = cvt_pk_bf16(h[0], h[1]); w.y = cvt_pk_bf16(h[2], h[3]); *(u32x2*)(o + 4 * F.lane + 256 * j) = w; } }
    }
}

constexpr int SGU_PITCH = 272;
constexpr int SGU_WAVE_BYTES = 64 * SGU_PITCH + 512;
__device__ __forceinline__ void p3_sgu(Frame& F) {
    const Params& p = F.p;
    LAS unsigned char* my = F.lds + F.wave * SGU_WAVE_BYTES;
    LAS float* rs = (LAS float*)(my + 64 * SGU_PITCH);
    const int g = F.wave, lane = F.lane, fr = lane & 15, fq = lane >> 4;
    const bf16_t* VV = (const bf16_t*)(p.ws + WS_VV); const bf16_t* U = (const bf16_t*)(p.ws + WS_U); const float* VSS = (const float*)(p.ws + WS_VSS);
    const bf16_t* WSB = (const bf16_t*)(p.ws + WS_WS_B) + (size_t)g * CHUNK * CHUNK;
    bf16_t* MIXo = (bf16_t*)(p.ws + WS_MIX);
    __syncthreads();
    for (int unit = F.bx; unit < MLAT / CHUNK; unit += F.G) {
        const int r0 = unit * CHUNK;
#pragma unroll
        for (int h = 0; h < 2; ++h) { const int j = lane + 64 * h; const f32x4 a = *(const f32x4*)(VSS + (size_t)(r0 + j) * 8), b = *(const f32x4*)(VSS + (size_t)(r0 + j) * 8 + 4);
            const float ss = ((a[0] + a[1]) + (a[2] + a[3])) + ((b[0] + b[1]) + (b[2] + b[3])); rs[j] = rsqrtf(ss * (1.f / DGM) + EPS); }
        LDS_WAIT();
        { const float s0 = rs[2 * lane], s1 = rs[2 * lane + 1];
          const bf16_t* src = VV + (size_t)(r0 + 2 * lane) * DGM + g * 64;
#pragma unroll
          for (int ch = 0; ch < 8; ++ch) { const u32x4 a = *(const u32x4*)(src + 8 * ch), b = *(const u32x4*)(src + DGM + 8 * ch);
#pragma unroll
              for (int q = 0; q < 4; ++q) { const unsigned ua = a[q], ub = b[q];
                  const float a0 = __uint_as_float(ua << 16) * s0, a1 = __uint_as_float(ua & 0xffff0000u) * s0, b0 = __uint_as_float(ub << 16) * s1, b1 = __uint_as_float(ub & 0xffff0000u) * s1;
                  *(LAS unsigned*)(my + (8 * ch + 2 * q) * SGU_PITCH + 4 * lane) = cvt_pk_bf16(a0, b0);
                  *(LAS unsigned*)(my + (8 * ch + 2 * q + 1) * SGU_PITCH + 4 * lane) = cvt_pk_bf16(a1, b1); } } }
        LDS_WAIT(); asm volatile("" ::: "memory");
#pragma unroll 1
        for (int ih = 0; ih < 2; ++ih) {
            bf16x8 bw[4][4]; u32x2 uu[4][4];
#pragma unroll
            for (int ks = 0; ks < 4; ++ks)
#pragma unroll
                for (int jf = 0; jf < 4; ++jf) bw[ks][jf] = *(const bf16x8*)(WSB + (size_t)(64 * ih + 16 * jf + fr) * CHUNK + 32 * ks + 8 * fq);
#pragma unroll
            for (int jf = 0; jf < 4; ++jf)
#pragma unroll
                for (int df = 0; df < 4; ++df) uu[jf][df] = *(const u32x2*)(U + (size_t)(r0 + 64 * ih + 16 * jf + fr) * DGM + g * 64 + 16 * df + 4 * fq);
            f32x4 acc[4][4];
#pragma unroll
            for (int df = 0; df < 4; ++df)
#pragma unroll
                for (int jf = 0; jf < 4; ++jf) acc[df][jf] = (f32x4){0.f, 0.f, 0.f, 0.f};
#pragma unroll
            for (int ks = 0; ks < 4; ++ks) {
                bf16x8 af[4];
#pragma unroll
                for (int df = 0; df < 4; ++df) af[df] = *(const LAS bf16x8*)(my + (16 * df + fr) * SGU_PITCH + 64 * ks + 16 * fq);
#pragma unroll
                for (int df = 0; df < 4; ++df)
#pragma unroll
                    for (int jf = 0; jf < 4; ++jf) acc[df][jf] = __builtin_amdgcn_mfma_f32_16x16x32_bf16(af[df], bw[ks][jf], acc[df][jf], 0, 0, 0);
            }
#pragma unroll
            for (int jf = 0; jf < 4; ++jf) { const int i = 64 * ih + 16 * jf + fr, row = r0 + i; const float bs = p.b_s[g * CHUNK + i];
#pragma unroll
                for (int df = 0; df < 4; ++df) { const int d = g * 64 + 16 * df + 4 * fq;
                    const f32x4 vg = *(const f32x4*)(p.v_gain + d); const u32x2 uv = uu[jf][df];
                    const f32x4 m = acc[df][jf] * vg + bs;
                    const float u0 = __uint_as_float(uv.x << 16), u1 = __uint_as_float(uv.x & 0xffff0000u), u2 = __uint_as_float(uv.y << 16), u3 = __uint_as_float(uv.y & 0xffff0000u);
                    u32x2 w; w.x = cvt_pk_bf16(u0 * m[0], u1 * m[1]); w.y = cvt_pk_bf16(u2 * m[2], u3 * m[3]);
                    *(u32x2*)(MIXo + (size_t)row * DM + DATT + d) = w; } }
        }
        LDS_WAIT(); asm volatile("" ::: "memory");
    }
}

__device__ __forceinline__ f32x4 x1_ld(const float* x, const bf16_t* proj, size_t off) {
    const f32x4 a = *(const f32x4*)(x + off); const u32x2 b = *(const u32x2*)(proj + off);
    return (f32x4){a[0] + __uint_as_float(b.x << 16), a[1] + __uint_as_float(b.x & 0xffff0000u), a[2] + __uint_as_float(b.y << 16), a[3] + __uint_as_float(b.y & 0xffff0000u)};
}
__device__ __forceinline__ void p5_router(Frame& F) {
    const Params& p = F.p;
    LAS f32x4* wl = (LAS f32x4*)F.lds;
    __syncthreads();
    for (int idx = F.tid; idx < DM * 4; idx += NTHREADS) { const int k = idx >> 2, s = idx & 3;
        wl[(k >> 2) * 17 + ((k & 3) << 2) + s] = *(const f32x4*)(p.w_router + (size_t)k * NE + 4 * s); }
    __syncthreads();
    const int lane = F.lane;
    const int gw = F.bx * NWAVES + F.wave, NGW = F.G * NWAVES;
    const float* modb = (const float*)(p.ws + WS_MOD);
    const bf16_t* pj = (const bf16_t*)(p.ws + WS_PROJ); bf16_t* x1b = (bf16_t*)(p.ws + WS_X1B);
    LAS f32x4* xb = (LAS f32x4*)(F.lds + 69632 + F.wave * 8192) + lane;
    float nrstd[2] = {0.f, 0.f};
    if (gw < MLAT / 2) {
#pragma unroll
        for (int r = 0; r < 2; ++r) { float ss = 0.f;
#pragma unroll
            for (int j = 0; j < 4; ++j) { const f32x4 xv = x1_ld(p.x, pj, (size_t)(2 * gw + r) * DM + 4 * lane + 256 * j); xb[(r * 4 + j) * 64] = xv; { u32x2 w; w.x = cvt_pk_bf16(xv[0], xv[1]); w.y = cvt_pk_bf16(xv[2], xv[3]); *(u32x2*)(x1b + (size_t)(2 * gw + r) * DM + 4 * lane + 256 * j) = w; } ss += (xv[0] * xv[0] + xv[1] * xv[1]) + (xv[2] * xv[2] + xv[3] * xv[3]); }
            nrstd[r] = rsqrtf(wave_sum(ss) * (1.f / DM) + EPS); }
    }
    for (int pr = gw; pr < MLAT / 2; pr += NGW) {
        const int row0 = 2 * pr, b = row0 >> 11, t0 = row0 & 2047;
        const float* mod = modb + b * 6144;
        const float rstd[2] = {nrstd[0], nrstd[1]};
        const int prn = (pr + NGW < MLAT / 2) ? pr + NGW : pr;
        f32x4 nx[2][4];
#pragma unroll
        for (int r = 0; r < 2; ++r)
#pragma unroll
            for (int j = 0; j < 4; ++j) nx[r][j] = x1_ld(p.x, pj, (size_t)(2 * prn + r) * DM + 4 * lane + 256 * j);
        float lg[2][16];
#pragma unroll
        for (int r = 0; r < 2; ++r)
#pragma unroll
            for (int e = 0; e < 16; ++e) lg[r][e] = 0.f;
        f32x4 cg = *(const f32x4*)(p.g_ffn + 4 * lane), csc = *(const f32x4*)(mod + 4096 + 4 * lane), csh = *(const f32x4*)(mod + 3072 + 4 * lane);
#pragma unroll 1
        for (int j = 0; j < 4; ++j) {
            const int k = 4 * lane + 256 * j, kn = 4 * lane + 256 * ((j + 1) & 3);
            const f32x4 ng = *(const f32x4*)(p.g_ffn + kn), nsc = *(const f32x4*)(mod + 4096 + kn), nsh = *(const f32x4*)(mod + 3072 + kn);
            const f32x4 cx0 = xb[j * 64], cx1 = xb[(4 + j) * 64];
            f32x4 h[2];
            h[0] = cx0 * rstd[0] * cg * (csc + 1.f) + csh; h[1] = cx1 * rstd[1] * cg * (csc + 1.f) + csh;
#pragma unroll
            for (int r = 0; r < 2; ++r)
                __builtin_nontemporal_store(pk4_fp8(h[r][0], h[r][1], h[r][2], h[r][3], A8_SCALE), (unsigned*)(p.ws + WS_H2 + (size_t)(row0 + r) * DM + k));
            const LAS f32x4* wj = wl + (lane + 64 * j) * 17;
#pragma unroll
            for (int q = 0; q < 4; ++q)
#pragma unroll
                for (int s = 0; s < 4; ++s) { const f32x4 w = wj[4 * q + s];
#pragma unroll
                    for (int r = 0; r < 2; ++r) { const float hv = h[r][q];
                        lg[r][4 * s + 0] += hv * w[0]; lg[r][4 * s + 1] += hv * w[1]; lg[r][4 * s + 2] += hv * w[2]; lg[r][4 * s + 3] += hv * w[3]; } }
            cg = ng; csc = nsc; csh = nsh;
        }
#pragma unroll
        for (int r = 0; r < 2; ++r) {
            float w8[8], w4[4], w2[2], w1;
            const bool b5 = lane & 32, b4 = lane & 16, b3 = lane & 8, b2 = lane & 4;
#pragma unroll
            for (int i = 0; i < 8; ++i) w8[i] = swap32_sum(lg[r][i], lg[r][i + 8]);
#pragma unroll
            for (int i = 0; i < 4; ++i) w4[i] = swap16_sum(w8[i], w8[i + 4]);
#pragma unroll
            for (int i = 0; i < 2; ++i) { const float send = b3 ? w4[i] : w4[i + 2], keep = b3 ? w4[i + 2] : w4[i]; w2[i] = keep + dpp_mov<DPP_MIRROR>(send); }
            { const float send = b2 ? w2[0] : w2[1], keep = b2 ? w2[1] : w2[0]; w1 = keep + dpp_mov<DPP_HMIRROR>(send); }
            w1 += dpp_mov<DPP_XOR2>(w1); w1 += dpp_mov<DPP_XOR1>(w1);
            float mx = w1;
            mx = fmaxf(mx, dpp_mov<DPP_HMIRROR>(mx)); mx = fmaxf(mx, dpp_mov<DPP_MIRROR>(mx)); mx = swap16_max(mx); mx = swap32_max(mx);
            const float ex = __expf(w1 - mx);
            float den = ex;
            den += dpp_mov<DPP_HMIRROR>(den); den += dpp_mov<DPP_MIRROR>(den); den = swap16_sum(den, den); den = swap32_sum(den, den);
            const int e = (b5 ? 8 : 0) + (b4 ? 4 : 0) + (b3 ? 2 : 0) + (b2 ? 1 : 0);
            if ((lane & 3) == 0) ((float*)(p.ws + WS_AFF))[((size_t)b * NE + e) * SEQ + t0 + r] = ex / den;
        }
#pragma unroll
        for (int r = 0; r < 2; ++r) { float ss = 0.f;
#pragma unroll
            for (int j = 0; j < 4; ++j) { xb[(r * 4 + j) * 64] = nx[r][j]; if (prn != pr) { u32x2 w; w.x = cvt_pk_bf16(nx[r][j][0], nx[r][j][1]); w.y = cvt_pk_bf16(nx[r][j][2], nx[r][j][3]); *(u32x2*)(x1b + (size_t)(2 * prn + r) * DM + 4 * lane + 256 * j) = w; } ss += (nx[r][j][0] * nx[r][j][0] + nx[r][j][1] * nx[r][j][1]) + (nx[r][j][2] * nx[r][j][2] + nx[r][j][3] * nx[r][j][3]); }
            nrstd[r] = rsqrtf(wave_sum(ss) * (1.f / DM) + EPS); }
    }
}

__device__ __forceinline__ void p6_topk(Frame& F) {
    const Params& p = F.p;
    LAS unsigned* hist = (LAS unsigned*)F.lds;
    LAS unsigned* sel = hist + 256;
    LAS unsigned* wsum = hist + 264;
    const int tid = F.tid, lane = F.lane;
    for (int be = F.bx; be < NB * NE; be += F.G) {
        const int b = be / NE, e = be % NE;
        const float* aff = (const float*)(p.ws + WS_AFF) + (size_t)be * SEQ;
        const f32x4 v = *(const f32x4*)(aff + 4 * tid);
        unsigned key[4];
#pragma unroll
        for (int i = 0; i < 4; ++i) key[i] = __float_as_uint(v[i]);
        unsigned prefix = 0u, need = CAP;
#pragma unroll
        for (int lvl = 0; lvl < 4; ++lvl) {
            const int sh = 24 - 8 * lvl;
            __syncthreads();
            if (tid < 256) hist[tid] = 0u;
            __syncthreads();
#pragma unroll
            for (int i = 0; i < 4; ++i) { const bool in = (lvl == 0) || ((key[i] >> (sh + 8)) == prefix); if (in) atomicAdd((unsigned*)&hist[(key[i] >> sh) & 255u], 1u); }
            __syncthreads();
            if (tid < 256) { unsigned gt = 0u; for (int j = tid + 1; j < 256; ++j) gt += hist[j];
                const unsigned hme = hist[tid];
                if (gt < need && need <= gt + hme) { sel[0] = (unsigned)tid; sel[1] = need - gt; } }
            __syncthreads();
            prefix = (prefix << 8) | sel[0]; need = sel[1];
        }
        const unsigned T = prefix, need_eq = need;
        unsigned cg_ = 0u, ce_ = 0u;
#pragma unroll
        for (int i = 0; i < 4; ++i) { cg_ += key[i] > T ? 1u : 0u; ce_ += key[i] == T ? 1u : 0u; }
        unsigned pk = cg_ | (ce_ << 16), inc = pk;
#pragma unroll
        for (int o = 1; o < 64; o <<= 1) { const unsigned n = __shfl_up(inc, o); if (lane >= o) inc += n; }
        __syncthreads();
        if (lane == 63) wsum[F.wave] = inc;
        __syncthreads();
        unsigned base = 0u;
        for (int w = 0; w < F.wave; ++w) base += wsum[w];
        unsigned run = base + inc - pk;
        int* idxo = (int*)(p.ws + WS_IDX) + be * CAP; float* gate = (float*)(p.ws + WS_GATE) + (e * NB + b) * CAP; int* inv = (int*)(p.ws + WS_INV);
#pragma unroll
        for (int i = 0; i < 4; ++i) { const int t = 4 * tid + i; const unsigned g_run = run & 0xffffu, e_run = run >> 16;
            const bool isgt = key[i] > T, iseq = key[i] == T;
            const bool take = isgt || (iseq && e_run < need_eq);
            const unsigned pos = g_run + (e_run < need_eq ? e_run : need_eq);
            if (take) { idxo[pos] = t; gate[pos] = v[i]; }
            inv[(size_t)(b * SEQ + t) * NE + e] = take ? (int)((e * NB + b) * CAP + pos) : -1;
            run += (isgt ? 1u : 0u) + (iseq ? 65536u : 0u); }
    }
}

__device__ __forceinline__ void p9_final(Frame& F, float* dst) {
    const Params& p = F.p;
    const int lane = F.lane, gw = F.bx * NWAVES + F.wave, NGW = F.G * NWAVES;
    const float* modb = (const float*)(p.ws + WS_MOD); const unsigned char* ye = p.ws + WS_YE; const int* invb = (const int*)(p.ws + WS_INV);
    for (int pr = gw; pr < MLAT / 2; pr += NGW) {
        const int row0 = 2 * pr;
        const float* mod = modb + (row0 >> 11) * 6144 + 5120;
        const int sl = invb[(size_t)row0 * NE + (lane & 31)];
        unsigned long long bal = __ballot(sl >= 0);
        unsigned msk[2] = {(unsigned)bal & 0xffffu, ((unsigned)bal >> 16) & 0xffffu};
        f32x4 xv[2][4]; unsigned yw[2][4][4]; float wt[2][4];
#pragma unroll
        for (int r = 0; r < 2; ++r) {
#pragma unroll
            for (int j = 0; j < 4; ++j) { const u32x2 w = *(const u32x2*)((const bf16_t*)(p.ws + WS_X1B) + (size_t)(row0 + r) * DM + 4 * lane + 256 * j);
                xv[r][j] = (f32x4){__uint_as_float(w.x << 16), __uint_as_float(w.x & 0xffff0000u), __uint_as_float(w.y << 16), __uint_as_float(w.y & 0xffff0000u)}; }
#pragma unroll
            for (int q = 0; q < 4; ++q) { int s = 0; wt[r][q] = 0.f;
                if (msk[r]) { const int e = __builtin_ctz(msk[r]); msk[r] &= msk[r] - 1; s = __builtin_amdgcn_readlane(sl, 16 * r + e); wt[r][q] = 1.f / YE8_SCALE; }
                s = __builtin_amdgcn_readfirstlane(s);
                const unsigned char* yr = ye + (size_t)s * DM + 4 * lane;
#pragma unroll
                for (int j = 0; j < 4; ++j) yw[r][q][j] = *(const unsigned*)(yr + 256 * j); }
        }
#pragma unroll
        for (int r = 0; r < 2; ++r) {
            f32x4 m[4];
#pragma unroll
            for (int j = 0; j < 4; ++j) { m[j] = (f32x4){0.f, 0.f, 0.f, 0.f};
#pragma unroll
                for (int q = 0; q < 4; ++q) { const unsigned w = yw[r][q][j]; const float t = wt[r][q];
                    const f32x2 lo = __builtin_amdgcn_cvt_pk_f32_fp8((int)w, false), hi = __builtin_amdgcn_cvt_pk_f32_fp8((int)w, true);
                    m[j][0] += t * lo[0]; m[j][1] += t * lo[1]; m[j][2] += t * hi[0]; m[j][3] += t * hi[1]; } }
            while (msk[r]) {
                const int e = __builtin_ctz(msk[r]); msk[r] &= msk[r] - 1; const int s = __builtin_amdgcn_readlane(sl, 16 * r + e);
                const unsigned char* yr = ye + (size_t)s * DM + 4 * lane;
#pragma unroll
                for (int j = 0; j < 4; ++j) { const unsigned w = *(const unsigned*)(yr + 256 * j);
                    const f32x2 lo = __builtin_amdgcn_cvt_pk_f32_fp8((int)w, false), hi = __builtin_amdgcn_cvt_pk_f32_fp8((int)w, true);
                    m[j][0] += lo[0] * (1.f / YE8_SCALE); m[j][1] += lo[1] * (1.f / YE8_SCALE); m[j][2] += hi[0] * (1.f / YE8_SCALE); m[j][3] += hi[1] * (1.f / YE8_SCALE); } }
            float ss = 0.f; f32x4 v[4];
#pragma unroll
            for (int j = 0; j < 4; ++j) { const int k = 4 * lane + 256 * j; const f32x4 gt = *(const f32x4*)(mod + k);
                v[j] = xv[r][j] + gt * m[j]; ss += (v[j][0] * v[j][0] + v[j][1] * v[j][1]) + (v[j][2] * v[j][2] + v[j][3] * v[j][3]); }
            const float rstd = rsqrtf(wave_sum(ss) * (1.f / DM) + EPS);
            float* xr = dst + (size_t)(row0 + r) * DM;
#pragma unroll
            for (int j = 0; j < 4; ++j) { const int k = 4 * lane + 256 * j; const f32x4 g = *(const f32x4*)(p.g_final + k); __builtin_nontemporal_store(v[j] * rstd * g, (f32x4*)(xr + k)); }
        }
    }
}

#ifndef FFN1_WGM
#define FFN1_WGM 8
#endif
#ifndef FFN2_WGM
#define FFN2_WGM 8
#endif
#ifndef PROBE_REP
#define PROBE_REP -1
#endif
struct Args { Params p; int ph_lo, ph_hi; };
constexpr int N_PHASES = 10;
__global__ void __launch_bounds__(NTHREADS, 2) mk_fwd(Args args) {
    extern __shared__ __attribute__((aligned(16))) unsigned char lds_raw[];
    Frame F;
    F.lds = (LAS unsigned char*)lds_raw;
    F.tid = threadIdx.x; F.lane = F.tid & 63; F.wave = __builtin_amdgcn_readfirstlane(F.tid >> 6);
    F.G = gridDim.x; F.bx = blockIdx.x; F.p = args.p;
    unsigned char* ws = F.p.ws;
    volatile LAS unsigned* bst = (volatile LAS unsigned*)(F.lds + LDS_BYTES - 64);
    if (F.tid < 2) bst[F.tid] = 0u;
    __syncthreads();
    XcdBarrier bar = xcd_barrier_post((unsigned*)ws, bst);
    if (args.ph_hi > 1000) cg::this_grid().sync();
    const int lo = args.ph_lo, hi = args.ph_hi;
#define IN(k) (lo <= (k) && (k) < hi)
#define GSYNC() xcd_barrier(bar)
#define SEAM(k) do { if (IN(k) && IN((k) + 1)) GSYNC(); } while (0)
#define PHASE(k, ...) do { if (IN(k)) { __VA_ARGS__; if (PROBE_REP == (k)) { GSYNC(); __VA_ARGS__; } } SEAM(k); } while (0)
    PHASE(0, p0_adaln(F));
    PHASE(1, { p1_modulate(F); p0_convert(F); });
    PHASE(2, {
        const ProbInProj P{ws}; const EpiInProj E{ws, F.p.q_gain, F.p.k_gain};
        InProjOrder S; S.init(F.G, F.bx);
        pg8::gemm_phase<ProbInProj, EpiInProj, InProjOrder, true>(F.lds, P, S, E);
        { const int nfull = (912 + F.G - 1) / F.G, nidle = nfull * F.G - 912; pg8::Unit ut;
          if (nidle > 0 && !S.next(nfull - 1, ut)) convert_experts(F, 0, CONV_EARLY, (F.bx - (F.G - nidle)) * NWAVES + F.wave, nidle * NWAVES); } });
    PHASE(3, {
        const int vcu = (F.G % 8 == 0) ? (F.bx % 8) * (F.G / 8) + F.bx / 8 : F.bx;
        const int conv_lo = ((912 + F.G - 1) / F.G * F.G - 912) > 0 ? CONV_EARLY : 0;
        const int nun = (1024 - vcu + F.G - 1) / F.G, stagger = ((F.bx >> 3) & 3) < nun ? ((F.bx >> 3) & 3) : nun;
        for (int i = 0; i <= nun; ++i) {
            if (i == stagger) convert_experts(F, conv_lo, CONV_NIT, F.bx * NWAVES + F.wave, F.G * NWAVES);
            if (i < nun) {
                const unsigned char* wsq = ws; asm volatile("" : "+s"(wsq));
                attn_body::attn_unit_L<8>(vcu + i * F.G, (char*)lds_raw, (const attn_body::bf16*)(wsq + WS_Q), (const attn_body::bf16*)(wsq + WS_K), (const attn_body::bf16*)(wsq + WS_V), (attn_body::bf16*)(wsq + WS_MIX));
            }
        }
        p3_sgu(F); });
    PHASE(4, {
        const ProbOutProj P{ws}; const EpiOutProj E{(bf16_t*)(ws + WS_PROJ), (const float*)(ws + WS_MOD)};
        pg8::StaticOrder S; S.init(MLAT, DM, F.G, F.bx);
        pg8::gemm_phase<ProbOutProj, EpiOutProj, pg8::StaticOrder, true>(F.lds, P, S, E); });
    PHASE(5, p5_router(F));
    PHASE(6, p6_topk(F));
    PHASE(7, {
        const ProbFfn1 P{ws}; const EpiFfn1 E{ws + WS_HID};
        pg8::StaticOrder S0; S0.init(NSLOT, 2 * FF, F.G, F.bx, 0, 1 << 30, FFN1_WGM);
        pg8::Unit u0, u1; int i = 0;
        while (S0.next(i, u0)) {
            int j = i + 1; while (S0.next(j, u1) && u1.pm == u0.pm) ++j;
            pg8::StaticOrder S; S.init(NSLOT, 2 * FF, F.G, F.bx, i, j, FFN1_WGM);
            pg8::gemm_phase<ProbFfn1, EpiFfn1, pg8::StaticOrder, true>(F.lds, P, S, E);
            i = j;
        } });
    PHASE(8, {
        const ProbFfn2 P{ws}; const EpiFfn2 E{ws + WS_YE, (const float*)(ws + WS_GATE)};
        pg8::StaticOrder S; S.init(NSLOT, DM, F.G, F.bx, 0, 1 << 30, FFN2_WGM);
        pg8::gemm_phase<ProbFfn2, EpiFfn2, pg8::StaticOrder, true>(F.lds, P, S, E); });
    if (PROBE_REP == 9 && IN(9)) { p9_final(F, (float*)(ws + WS_HID)); GSYNC(); }
    if (PROBE_REP == 10 && IN(9)) { for (int i = 0; i < 8; ++i) GSYNC(); }
    if (IN(9)) p9_final(F, F.p.out);
#undef IN
#undef SEAM
#undef GSYNC
#undef PHASE
}

extern "C" void kernel_launch(void* const* d_in, const int* in_sizes, int n_in, void* d_out, int out_size, void* d_ws, size_t ws_size, hipStream_t stream) {
    if (n_in != 20 || ws_size < WS_END) return;
    static int grid_blocks = 0;
    if (!grid_blocks) {
        int dev = 0, cus = 0, per_cu = 0;
        (void)hipGetDevice(&dev);
        (void)hipDeviceGetAttribute(&cus, hipDeviceAttributeMultiprocessorCount, dev);
        (void)hipFuncSetAttribute((const void*)mk_fwd, hipFuncAttributeMaxDynamicSharedMemorySize, LDS_BYTES);
        (void)hipOccupancyMaxActiveBlocksPerMultiprocessor(&per_cu, (const void*)mk_fwd, NTHREADS, LDS_BYTES);
        grid_blocks = (per_cu >= 1) ? cus : 0;
        if (grid_blocks <= 0) grid_blocks = -1;
    }
    if (grid_blocks < 0) return;
    Args a{};
    const float** f = (const float**)&a.p;
    for (int i = 0; i < 20; ++i) f[i] = (const float*)d_in[i];
    a.p.out = (float*)d_out; a.p.ws = (unsigned char*)d_ws;
    a.ph_lo = 0; a.ph_hi = N_PHASES;
    (void)hipMemsetAsync(d_ws, 0, 16384, stream);
    void* kargs[] = {&a};
    (void)hipLaunchCooperativeKernel((void*)mk_fwd, dim3(grid_blocks), dim3(NTHREADS), kargs, LDS_BYTES, stream);
}
```

```cpp
#include <hip/hip_runtime.h>
#include <stdint.h>

typedef unsigned short bf16_t;
__device__ __forceinline__ float bf2f(bf16_t v) { return __uint_as_float(((unsigned)v) << 16); }
__device__ __forceinline__ bf16_t f2bf(float f) { unsigned u = __float_as_uint(f); return (bf16_t)((u + 0x7fffu + ((u >> 16) & 1u)) >> 16); }

constexpr int NB = 16, SEQ = 2048, DM = 1024, CTXL = 256, NKEY = SEQ + CTXL;
constexpr int HD = 64, NQH = 8, NKVH = 2, DATT = 512, DKV = 128, DGM = 512, CHUNK = 128, NGRP = 8;
constexpr int DIN = 1792, NE = 16, CAP = 256, FF = 2048;
constexpr int MLAT = NB * SEQ;
constexpr int MCTX = NB * CTXL;
constexpr int MALL = MLAT + MCTX;
constexpr int NSLOT = NB * NE * CAP;
constexpr float EPS = 1e-6f;
constexpr float QSCALE = 0.125f * 1.4426950408889634f;

constexpr size_t MiB = 1u << 20;
constexpr size_t WS_MOD = 1 * MiB;
constexpr size_t WS_ROPE = 2 * MiB;
constexpr size_t WS_AFF = 3 * MiB;
constexpr size_t WS_IDX = 5 * MiB;
constexpr size_t WS_GATE = 6 * MiB;
constexpr size_t WS_INV = 7 * MiB;
constexpr size_t WS_WBF = 10 * MiB;
constexpr size_t WS_H2 = 210 * MiB;
constexpr size_t WS_A = 276 * MiB;
constexpr size_t WS_XN = WS_A;
constexpr size_t WS_Q = WS_A + 72 * MiB;
constexpr size_t WS_K = WS_A + 104 * MiB;
constexpr size_t WS_V = WS_A + 113 * MiB;
constexpr size_t WS_U = WS_A + 122 * MiB;
constexpr size_t WS_VV = WS_A + 154 * MiB;
constexpr size_t WS_VSS = WS_A + 186 * MiB;
constexpr size_t WS_MIX = WS_A + 188 * MiB;
constexpr size_t WS_X1B = WS_MIX;
constexpr size_t WS_HID = WS_A;
constexpr size_t WS_YE = WS_WBF + 70 * MiB;
constexpr size_t WS_PROJ = WS_WBF + 134 * MiB;
constexpr size_t WS_END = 532 * MiB;

struct Params {
    const float *x, *c, *ctx, *c_ctx, *w_mod, *b_mod, *g_mix, *g_ffn, *w_in, *q_gain, *k_gain, *v_gain, *w_s, *b_s, *w_out, *w_router, *w1, *w3, *w2, *g_final;
    float* out; unsigned char* ws;
};

__device__ __forceinline__ float silu_f(float v) { return v / (1.f + __expf(-v)); }
__device__ __forceinline__ float gelu_f(float v) { return 0.5f * v * (1.f + erff(v * 0.70710678118654752f)); }

#include <hip/hip_cooperative_groups.h>
namespace cg = cooperative_groups;

#define LAS __attribute__((address_space(3)))
#define GAS __attribute__((address_space(1)))
typedef short bf16x8 __attribute__((ext_vector_type(8)));
typedef float f32x4 __attribute__((ext_vector_type(4)));
typedef float f32x2 __attribute__((ext_vector_type(2)));
typedef unsigned u32x4 __attribute__((ext_vector_type(4)));
typedef unsigned u32x2 __attribute__((ext_vector_type(2)));

__device__ __forceinline__ unsigned cvt_pk_bf16(float lo, float hi) {
    typedef __bf16 bf16x2_t __attribute__((ext_vector_type(2)));
    f32x2 v = {lo, hi}; bf16x2_t b = __builtin_convertvector(v, bf16x2_t); return __builtin_bit_cast(unsigned, b);
}
__device__ __forceinline__ float fast_silu(float v) { return v * __builtin_amdgcn_rcpf(1.f + __expf(-v)); }
__device__ __forceinline__ float fast_gelu(float v) {
    const float av = fabsf(v), t = __builtin_amdgcn_rcpf(av * 0.2316418882f + 1.0f);
    float q = t * 0.5307027145f + (-0.7265760135f); q = q * t + 0.7107068705f; q = q * t + (-0.142248368f); q = q * t + 0.127414796f; q = q * t;
    const float e = __builtin_amdgcn_exp2f((v * v) * (-0.72134752044f));
    const float m = v * (q * e);
    return v < 0.f ? m : v - m;
}

namespace pg8 {
constexpr int BM = 256, BK = 64, HALF = 128, HTB = HALF * BK * 2  , STAGE_BYTES = 8 * HTB, NXCD = 8, WGM = 8;
__host__ __device__ __forceinline__ int lds_byte(int r, int c) { const int rr = r & 7, f = ((rr >> 1) & 3) << 1; return (r >> 3) * 1024 + rr * 128 + ((((c >> 3) ^ f)) << 4) + (c & 7) * 2; }
__host__ __device__ __forceinline__ void stage_rc(int b, int& R, int& C) { const int sb = b % 1024, rr = sb >> 7, f = ((rr >> 1) & 3) << 1; R = (b / 1024) * 8 + rr; C = (((sb >> 4) & 7) ^ f) * 8; }
__host__ __device__ __forceinline__ int perm32(int rho) { const int n = rho >> 4, i = rho & 15; return 8 * (i >> 2) + 4 * n + (i & 3); }

struct Unit { int pm, pn; };
typedef int v8i __attribute__((ext_vector_type(8)));
typedef int v4i __attribute__((ext_vector_type(4)));
__device__ __forceinline__ bf16x8 lo8(v8i v) { return __builtin_bit_cast(bf16x8, __builtin_shufflevector(v, v, 0, 1, 2, 3)); }
__device__ __forceinline__ bf16x8 hi8(v8i v) { return __builtin_bit_cast(bf16x8, __builtin_shufflevector(v, v, 4, 5, 6, 7)); }

struct StaticOrder {
    int nM, nN, nwg, G, c, i0, i1, wgm;
    __device__ void init(int M, int N, int G_, int c_, int i0_ = 0, int i1_ = 1 << 30, int wgm_ = WGM) { nM = M / BM; nN = N / BM; nwg = nM * nN; G = G_; c = c_; i0 = i0_; i1 = i1_; wgm = wgm_; }
    __device__ bool next(int j, Unit& u) const {
        const int i = i0 + j; if (i >= i1) return false;
        const long L = (long)i * G + c; if (L >= nwg) return false;
        int wgid = (int)L; { const int q = nwg / NXCD, r = nwg % NXCD, xcd = wgid % NXCD, off = wgid / NXCD; wgid = (xcd < r ? xcd * (q + 1) : r * (q + 1) + (xcd - r) * q) + off; }
        const int nig = wgm * nN, gid = wgid / nig, fm = gid * wgm, gsz = (nM - fm) < wgm ? (nM - fm) : wgm;
        u.pm = fm + ((wgid % nig) % gsz); u.pn = (wgid % nig) / gsz; return true;
    }
};

template <class Prob, class Epi, class Sched, bool ALIGN_EPI>
__device__ __forceinline__ void gemm_phase(LAS unsigned char* lds, const Prob& P, const Sched& S, const Epi& E) {
    const int tid = threadIdx.x, wid = __builtin_amdgcn_readfirstlane(tid >> 6), lane = tid & 63, wr = wid >> 2, wc = wid & 3, fr = lane & 15, fq = lane >> 4;
    constexpr bool FP8 = Prob::FP8;
    constexpr int K = Prob::K, PB = FP8 ? K : 2 * K  , nt = PB / 128;
    Unit cur, nxt; int ui = 0;
    if (!S.next(0, cur)) return;
    unsigned voffA[2][2], voffB[2];
#pragma unroll
    for (int i = 0; i < 2; ++i) { int R, C; stage_rc(tid * 16 + i * 8192, R, C); const int Rb = Epi::PERM ? ((R & ~31) + perm32(R & 31)) : R;
        voffA[0][i] = P.a_offs(cur, R, C); voffA[1][i] = P.a_offs(cur, R + HALF, C); voffB[i] = (unsigned)(Rb * PB + C * 2); }
    const size_t kstep = (size_t)(BK * 2);
    const size_t hstepB = (size_t)HALF * PB;
    const unsigned ldsw = (unsigned)wid * 1024u;
    const int aoff = lds_byte(wr * 64 + fr, fq * 8), boff = lds_byte(wc * 32 + fr, fq * 8), aoff1 = aoff ^ 64, boff1 = boff ^ 64;
#define PG8_SA(b, h) (((b) * 2 + (h)) * HTB)
#define PG8_SB(b, h) ((4 + (b) * 2 + (h)) * HTB)
#define PG8_STAGE(bufoff, gbase, voff) do { _Pragma("unroll") for (int _i = 0; _i < 2; ++_i) \
        __builtin_amdgcn_global_load_lds((const unsigned*)((const char*)(gbase) + (voff)[_i]), (LAS unsigned*)(lds + (bufoff) + ldsw + _i * 8192), 16, 0, 0); } while (0)
#define PG8_STAGE_A(b, h, gbase) PG8_STAGE(PG8_SA(b, h), gbase, voffA[h])
#define PG8_STAGE_B(b, h, gbase) PG8_STAGE(PG8_SB(b, h), (gbase) + (h) * hstepB, voffB)
#define PG8_LD8(b0, b1) __builtin_shufflevector(*(const LAS v4i*)(b0), *(const LAS v4i*)(b1), 0, 1, 2, 3, 4, 5, 6, 7)
#define PG8_LDA(dst, b, h) do { _Pragma("unroll") for (int m = 0; m < 4; ++m) dst[m] = PG8_LD8(lds + PG8_SA(b, h) + aoff + m * 2048, lds + PG8_SA(b, h) + aoff1 + m * 2048); } while (0)
#define PG8_LDB(dst, b, h) do { _Pragma("unroll") for (int n = 0; n < 2; ++n) dst[n] = PG8_LD8(lds + PG8_SB(b, h) + boff + n * 2048, lds + PG8_SB(b, h) + boff1 + n * 2048); } while (0)
#define PG8_MMA(ai, bj, At, Bt) do { __builtin_amdgcn_s_setprio(1); _Pragma("unroll") for (int m = 0; m < 4; ++m) _Pragma("unroll") for (int n = 0; n < 2; ++n) { \
        if constexpr (FP8) asm volatile("v_mfma_scale_f32_16x16x128_f8f6f4 %0, %1, %2, %0, %3, %4 op_sel_hi:[0,0,0]" : "+v"(acc[ai][bj][m][n]) : "v"(Bt[n]), "v"(At[m]), "v"(sclB), "v"(sclA)); \
        else { acc[ai][bj][m][n] = __builtin_amdgcn_mfma_f32_16x16x32_bf16(lo8(Bt[n]), lo8(At[m]), acc[ai][bj][m][n], 0, 0, 0); \
               acc[ai][bj][m][n] = __builtin_amdgcn_mfma_f32_16x16x32_bf16(hi8(Bt[n]), hi8(At[m]), acc[ai][bj][m][n], 0, 0, 0); } } \
        __builtin_amdgcn_s_setprio(0); } while (0)
#define PG8_WAIT_V(n) asm volatile("s_waitcnt vmcnt(" #n ")" ::: "memory")
#define PG8_WAIT_L(n) asm volatile("s_waitcnt lgkmcnt(" #n ")" ::: "memory")
#define PG8_BAR __builtin_amdgcn_s_barrier()
#define PG8_SCHED __builtin_amdgcn_sched_barrier(0)
    f32x4 acc[2][2][4][2];
#pragma unroll
    for (int a = 0; a < 2; ++a)
#pragma unroll
        for (int b = 0; b < 2; ++b)
#pragma unroll
            for (int m = 0; m < 4; ++m)
#pragma unroll
                for (int n = 0; n < 2; ++n) acc[a][b][m][n] = (f32x4){0.f, 0.f, 0.f, 0.f};
    const int sclA = Prob::SCALE_A, sclB = Prob::SCALE_B;
    v8i At[4], B0[2], B1[2];
    const char* cA = P.a_base(cur); const char* cB = P.b_base(cur);
    PG8_STAGE_B(0, 0, cB); PG8_STAGE_B(0, 1, cB); PG8_STAGE_A(0, 0, cA); PG8_STAGE_A(0, 1, cA);
    if (wr == 1) PG8_BAR;
    PG8_WAIT_V(2); PG8_BAR;
    PG8_STAGE_B(1, 0, cB + kstep); PG8_STAGE_A(1, 0, cA + kstep); PG8_STAGE_B(1, 1, cB + kstep);
    PG8_WAIT_V(6); PG8_BAR;
    for (;;) {
        const bool has_next = S.next(ui + 1, nxt);
        const char* nA = has_next ? P.a_base(nxt) : cA; const char* nB = has_next ? P.b_base(nxt) : cB;
#pragma unroll 1
        for (int t = 0; t < nt; t += 2) {
            const bool last = (t == nt - 2);
            const char* a1 = cA + (size_t)(t + 1) * kstep;
            const char* a2 = last ? nA : cA + (size_t)(t + 2) * kstep; const char* b2 = last ? nB : cB + (size_t)(t + 2) * kstep;
            const char* a3 = a2 + kstep; const char* b3 = b2 + kstep;
            PG8_LDB(B0, 0, 0); PG8_LDB(B1, 0, 1); PG8_SCHED; PG8_LDA(At, 0, 0); PG8_STAGE_A(1, 1, a1);
            PG8_WAIT_V(8); PG8_WAIT_L(0); PG8_BAR; PG8_MMA(0, 0, At, B0); PG8_MMA(0, 1, At, B1); PG8_BAR; PG8_SCHED;
            PG8_LDA(At, 0, 1); PG8_STAGE_B(0, 0, b2); PG8_STAGE_B(0, 1, b2); PG8_STAGE_A(0, 0, a2);
            PG8_WAIT_V(8); PG8_WAIT_L(0); PG8_BAR; PG8_MMA(1, 0, At, B0); PG8_MMA(1, 1, At, B1); PG8_BAR; PG8_SCHED;
            PG8_LDB(B0, 1, 0); PG8_LDB(B1, 1, 1); PG8_SCHED; PG8_LDA(At, 1, 0); PG8_STAGE_A(0, 1, a2);
            PG8_WAIT_V(8); PG8_WAIT_L(0); PG8_BAR; PG8_MMA(0, 0, At, B0); PG8_MMA(0, 1, At, B1); PG8_BAR; PG8_SCHED;
            PG8_LDA(At, 1, 1); PG8_STAGE_B(1, 0, b3); PG8_STAGE_B(1, 1, b3); PG8_STAGE_A(1, 0, a3);
            PG8_WAIT_V(8); PG8_WAIT_L(0); PG8_BAR; PG8_MMA(1, 0, At, B0); PG8_MMA(1, 1, At, B1); PG8_BAR; PG8_SCHED;
        }
        if constexpr (ALIGN_EPI) { if (wr == 0) PG8_BAR; }
        if constexpr (FP8) {
#pragma unroll
            for (int a = 0; a < 2; ++a)
#pragma unroll
                for (int b = 0; b < 2; ++b) asm volatile("s_nop 15\n\ts_nop 7" : "+v"(acc[a][b][0][0]), "+v"(acc[a][b][0][1]), "+v"(acc[a][b][1][0]), "+v"(acc[a][b][1][1]), "+v"(acc[a][b][2][0]), "+v"(acc[a][b][2][1]), "+v"(acc[a][b][3][0]), "+v"(acc[a][b][3][1]));
        }
        E(acc, cur, wr, wc, fr, fq);
        if (!has_next) break;
#pragma unroll
        for (int a = 0; a < 2; ++a)
#pragma unroll
            for (int b = 0; b < 2; ++b)
#pragma unroll
                for (int m = 0; m < 4; ++m)
#pragma unroll
                    for (int n = 0; n < 2; ++n) acc[a][b][m][n] = (f32x4){0.f, 0.f, 0.f, 0.f};
        cur = nxt; cA = nA; cB = nB; ++ui;
        if constexpr (ALIGN_EPI) { if (wr == 1) PG8_BAR; }
    }
    PG8_WAIT_V(0);
    if constexpr (!ALIGN_EPI) { if (wr == 0) PG8_BAR; }
    PG8_BAR;
#undef PG8_SA
#undef PG8_SB
#undef PG8_STAGE
#undef PG8_STAGE_A
#undef PG8_STAGE_B
#undef PG8_LDA
#undef PG8_LD8
#undef PG8_LDB
#undef PG8_MMA
#undef PG8_WAIT_V
#undef PG8_WAIT_L
#undef PG8_BAR
#undef PG8_SCHED
}
}

constexpr size_t WS_WIN_T = WS_WBF;
constexpr size_t WS_WOUT_T = WS_WIN_T + (size_t)DIN * DM * 2;
constexpr size_t WS_WS_B = WS_WOUT_T + (size_t)DM * DM * 2;
constexpr size_t WS_W2_T = WS_WS_B + (size_t)NGRP * CHUNK * CHUNK * 2;
constexpr size_t WS_W13_T = WS_WBF + 70 * MiB;
static_assert(WS_W2_T + (size_t)NE * DM * FF * 2 <= WS_W13_T && WS_W13_T + (size_t)NE * 2 * FF * DM * 2 <= WS_H2, "weight copies");

constexpr float W8_SCALE = 256.f, A8_SCALE = 8.f;
constexpr int E8M0_W = 0x77777777  , E8M0_A = 0x7c7c7c7c  ;
__device__ __forceinline__ unsigned pk4_fp8(float a, float b, float c, float d, float s) {
    a = fminf(fmaxf(a * s, -448.f), 448.f); b = fminf(fmaxf(b * s, -448.f), 448.f); c = fminf(fmaxf(c * s, -448.f), 448.f); d = fminf(fmaxf(d * s, -448.f), 448.f);
    int w = __builtin_amdgcn_cvt_pk_fp8_f32(a, b, 0, false); w = __builtin_amdgcn_cvt_pk_fp8_f32(c, d, w, true); return (unsigned)w;
}
struct ProbFfn1 {
    static constexpr int K = DM; static constexpr bool FP8 = true; static constexpr int SCALE_A = E8M0_A, SCALE_B = E8M0_W;
    const unsigned char* ws;
    __device__ __forceinline__ const char* a_base(const pg8::Unit& u) const { return (const char*)(ws + WS_H2) + (size_t)(u.pm % NB) * SEQ * DM; }
    __device__ __forceinline__ const char* b_base(const pg8::Unit& u) const { return (const char*)(ws + WS_W13_T) + ((size_t)(u.pm / NB) * 16 + u.pn) * (size_t)256 * DM; }
    __device__ __forceinline__ unsigned a_offs(const pg8::Unit& u, int R, int C) const {
        const int e = u.pm / NB, b = u.pm % NB; const int t = ((const int*)(ws + WS_IDX))[(b * NE + e) * CAP + R];
        return (unsigned)(t * DM + C * 2); }
};
struct EpiFfn1 {
    static constexpr bool PERM = true;
    unsigned char* hid;
    __device__ __forceinline__ void operator()(const f32x4 (&acc)[2][2][4][2], const pg8::Unit& u, int wr, int wc, int fr, int fq) const {
        const int row0 = u.pm * 256 + wr * 64 + fr, col0 = u.pn * 128 + wc * 32 + 8 * fq;
#pragma unroll
        for (int ai = 0; ai < 2; ++ai)
#pragma unroll
            for (int m = 0; m < 4; ++m) {
                const f32x4 a0 = acc[ai][0][m][0], a1 = acc[ai][0][m][1], g0 = acc[ai][1][m][0], g1 = acc[ai][1][m][1];
                u32x2 w;
                w.x = pk4_fp8(fast_silu(a0[0]) * g0[0], fast_silu(a0[1]) * g0[1], fast_silu(a0[2]) * g0[2], fast_silu(a0[3]) * g0[3], A8_SCALE);
                w.y = pk4_fp8(fast_silu(a1[0]) * g1[0], fast_silu(a1[1]) * g1[1], fast_silu(a1[2]) * g1[2], fast_silu(a1[3]) * g1[3], A8_SCALE);
                *(u32x2*)(hid + (size_t)(row0 + ai * 128 + m * 16) * FF + col0) = w;
            }
    }
};
struct ProbFfn2 {
    static constexpr int K = FF; static constexpr bool FP8 = true; static constexpr int SCALE_A = E8M0_A, SCALE_B = E8M0_W;
    const unsigned char* ws;
    __device__ __forceinline__ const char* a_base(const pg8::Unit& u) const { return (const char*)(ws + WS_HID) + (size_t)u.pm * 256 * FF; }
    __device__ __forceinline__ const char* b_base(const pg8::Unit& u) const { return (const char*)(ws + WS_W2_T) + ((size_t)(u.pm / NB) * 4 + u.pn) * (size_t)256 * FF; }
    __device__ __forceinline__ unsigned a_offs(const pg8::Unit&, int R, int C) const { return (unsigned)(R * FF + C * 2); }
};
constexpr float YE8_SCALE = 64.f;
struct EpiFfn2 {
    static constexpr bool PERM = true;
    unsigned char* ye; const float* gate;
    __device__ __forceinline__ void operator()(const f32x4 (&acc)[2][2][4][2], const pg8::Unit& u, int wr, int wc, int fr, int fq) const {
        const int row0 = u.pm * 256 + wr * 64 + fr, col0 = u.pn * 256 + wc * 32 + 8 * fq;
#pragma unroll
        for (int ai = 0; ai < 2; ++ai)
#pragma unroll
            for (int m = 0; m < 4; ++m) { const int row = row0 + ai * 128 + m * 16; const float g = gate[row] * YE8_SCALE;
#pragma unroll
                for (int bj = 0; bj < 2; ++bj) { const f32x4 v0 = acc[ai][bj][m][0], v1 = acc[ai][bj][m][1];
                    u32x2 w; w.x = pk4_fp8(v0[0], v0[1], v0[2], v0[3], g); w.y = pk4_fp8(v1[0], v1[1], v1[2], v1[3], g);
                    *(u32x2*)(ye + (size_t)row * DM + col0 + bj * 128) = w; } }
    }
};

struct ProbInProj {
    static constexpr int K = DM; static constexpr bool FP8 = false; static constexpr int SCALE_A = 0, SCALE_B = 0;
    const unsigned char* ws;
    __device__ __forceinline__ const char* a_base(const pg8::Unit& u) const { return (const char*)(ws + WS_XN) + (size_t)u.pm * 256 * DM * 2; }
    __device__ __forceinline__ const char* b_base(const pg8::Unit& u) const { return (const char*)(ws + WS_WIN_T) + (size_t)u.pn * 256 * DM * 2; }
    __device__ __forceinline__ unsigned a_offs(const pg8::Unit&, int R, int C) const { return (unsigned)(R * DM + C) * 2u; }
};
struct InProjOrder {
    pg8::StaticOrder so; int G, c;
    __device__ void init(int G_, int c_) { so.init(MLAT, DIN, G_, c_); G = G_; c = c_; }
    __device__ bool next(int j, pg8::Unit& u) const {
        const int L = j * G + c;
        if (L < 896) return so.next(j, u);
        if (L < 896 + MCTX / 256) { u.pm = MLAT / 256 + (L - 896); u.pn = 2; return true; }
        return false;
    }
};
struct EpiInProj {
    static constexpr bool PERM = true;
    unsigned char* ws; const float* q_gain; const float* k_gain;
    __device__ __forceinline__ void operator()(const f32x4 (&acc)[2][2][4][2], const pg8::Unit& u, int wr, int wc, int fr, int fq) const {
        const int T = u.pn, rbase = u.pm * 256 + wr * 64 + fr;
        if (T <= 2) {
            const bool lat = u.pm < MLAT / 256;
            if (T == 2 && wc >= 2) {
                bf16_t* V = (bf16_t*)(ws + WS_V);
#pragma unroll
                for (int ai = 0; ai < 2; ++ai)
#pragma unroll
                    for (int m = 0; m < 4; ++m) { const int row = rbase + ai * 128 + m * 16; int b, s;
                        if (lat) { b = row >> 11; s = row & 2047; } else { const int rc = row - MLAT; b = rc >> 8; s = SEQ + (rc & 255); }
                        bf16_t* dst = V + ((size_t)b * NKEY + s) * DKV + (wc - 2) * 64 + 8 * fq;
#pragma unroll
                        for (int bj = 0; bj < 2; ++bj) { const f32x4 v0 = acc[ai][bj][m][0], v1 = acc[ai][bj][m][1];
                            u32x4 w; w.x = cvt_pk_bf16(v0[0], v0[1]); w.y = cvt_pk_bf16(v0[2], v0[3]); w.z = cvt_pk_bf16(v1[0], v1[1]); w.w = cvt_pk_bf16(v1[2], v1[3]);
                            *(u32x4*)(dst + 32 * bj) = w; } }
            } else {
                const bool isq = T < 2;
                const float* gain = isq ? q_gain : k_gain;
                const f32x4 g00 = *(const f32x4*)(gain + 8 * fq), g01 = *(const f32x4*)(gain + 8 * fq + 4), g10 = *(const f32x4*)(gain + 32 + 8 * fq), g11 = *(const f32x4*)(gain + 32 + 8 * fq + 4);
                const float* cs = (const float*)(ws + WS_ROPE); const float* sn = cs + 2048 * 32;
                const float osc = isq ? QSCALE : 1.f;
#pragma unroll
                for (int ai = 0; ai < 2; ++ai)
#pragma unroll
                    for (int m = 0; m < 4; ++m) { const int row = rbase + ai * 128 + m * 16; int b, s;
                        if (lat) { b = row >> 11; s = row & 2047; } else { const int rc = row - MLAT; b = rc >> 8; s = SEQ + (rc & 255); }
                        const f32x4 a00 = acc[ai][0][m][0], a01 = acc[ai][0][m][1], a10 = acc[ai][1][m][0], a11 = acc[ai][1][m][1];
                        float ss = 0.f;
#pragma unroll
                        for (int e = 0; e < 4; ++e) ss += (a00[e] * a00[e] + a01[e] * a01[e]) + (a10[e] * a10[e] + a11[e] * a11[e]);
                        ss += __shfl_xor(ss, 16); ss += __shfl_xor(ss, 32);
                        const float rstd = rsqrtf(ss * (1.f / 64.f) + EPS) ;
                        f32x4 y00 = a00 * g00 * rstd, y01 = a01 * g01 * rstd, y10 = a10 * g10 * rstd, y11 = a11 * g11 * rstd;
                        if (lat) {
                            const f32x4 c0 = *(const f32x4*)(cs + s * 32 + 8 * fq), c1 = *(const f32x4*)(cs + s * 32 + 8 * fq + 4), s0 = *(const f32x4*)(sn + s * 32 + 8 * fq), s1 = *(const f32x4*)(sn + s * 32 + 8 * fq + 4);
                            const f32x4 o00 = y00 * c0 - y10 * s0, o10 = y00 * s0 + y10 * c0, o01 = y01 * c1 - y11 * s1, o11 = y01 * s1 + y11 * c1;
                            y00 = o00; y10 = o10; y01 = o01; y11 = o11;
                        }
                        y00 = y00 * osc; y01 = y01 * osc; y10 = y10 * osc; y11 = y11 * osc;
                        bf16_t* dst = isq ? (bf16_t*)(ws + WS_Q) + (size_t)row * DATT + (4 * T + wc) * 64 + 8 * fq
                                          : (bf16_t*)(ws + WS_K) + ((size_t)b * NKEY + s) * DKV + wc * 64 + 8 * fq;
                        u32x4 w0, w1; w0.x = cvt_pk_bf16(y00[0], y00[1]); w0.y = cvt_pk_bf16(y00[2], y00[3]); w0.z = cvt_pk_bf16(y01[0], y01[1]); w0.w = cvt_pk_bf16(y01[2], y01[3]);
                        w1.x = cvt_pk_bf16(y10[0], y10[1]); w1.y = cvt_pk_bf16(y10[2], y10[3]); w1.z = cvt_pk_bf16(y11[0], y11[1]); w1.w = cvt_pk_bf16(y11[2], y11[3]);
                        *(u32x4*)(dst) = w0; *(u32x4*)(dst + 32) = w1; }
            }
        } else {
            const bool isu = T <= 4;
            bf16_t* O = isu ? (bf16_t*)(ws + WS_U) : (bf16_t*)(ws + WS_VV);
            const int colt = 256 * (T - (isu ? 3 : 5)) + wc * 32 + 8 * fq;
            float* vss = (float*)(ws + WS_VSS);
#pragma unroll
            for (int ai = 0; ai < 2; ++ai)
#pragma unroll
                for (int m = 0; m < 4; ++m) { const int row = rbase + ai * 128 + m * 16; float ss = 0.f;
#pragma unroll
                    for (int bj = 0; bj < 2; ++bj) { f32x4 v0 = acc[ai][bj][m][0], v1 = acc[ai][bj][m][1];
#pragma unroll
                        for (int e = 0; e < 4; ++e) { v0[e] = fast_gelu(v0[e]); v1[e] = fast_gelu(v1[e]); ss += v0[e] * v0[e] + v1[e] * v1[e]; }
                        u32x4 w; w.x = cvt_pk_bf16(v0[0], v0[1]); w.y = cvt_pk_bf16(v0[2], v0[3]); w.z = cvt_pk_bf16(v1[0], v1[1]); w.w = cvt_pk_bf16(v1[2], v1[3]);
                        *(u32x4*)(O + (size_t)row * DGM + colt + bj * 128) = w; }
                    if (!isu) { ss += __shfl_xor(ss, 16); ss += __shfl_xor(ss, 32); if (fq == 0) vss[(size_t)row * 8 + (T - 5) * 4 + wc] = ss; } }
        }
    }
};
struct ProbOutProj {
    static constexpr int K = DM; static constexpr bool FP8 = false; static constexpr int SCALE_A = 0, SCALE_B = 0;
    const unsigned char* ws;
    __device__ __forceinline__ const char* a_base(const pg8::Unit& u) const { return (const char*)(ws + WS_MIX) + (size_t)u.pm * 256 * DM * 2; }
    __device__ __forceinline__ const char* b_base(const pg8::Unit& u) const { return (const char*)(ws + WS_WOUT_T) + (size_t)u.pn * 256 * DM * 2; }
    __device__ __forceinline__ unsigned a_offs(const pg8::Unit&, int R, int C) const { return (unsigned)(R * DM + C) * 2u; }
};
struct EpiOutProj {
    static constexpr bool PERM = true;
    bf16_t* proj; const float* mod;
    __device__ __forceinline__ void operator()(const f32x4 (&acc)[2][2][4][2], const pg8::Unit& u, int wr, int wc, int fr, int fq) const {
        const int row0 = u.pm * 256 + wr * 64 + fr, col0 = u.pn * 256 + wc * 32 + 8 * fq;
        const float* gt = mod + (u.pm >> 3) * 6144 + 2048 + col0;
        f32x4 g[2][2];
#pragma unroll
        for (int bj = 0; bj < 2; ++bj)
#pragma unroll
            for (int n = 0; n < 2; ++n) g[bj][n] = *(const f32x4*)(gt + bj * 128 + 4 * n);
#pragma unroll
        for (int ai = 0; ai < 2; ++ai)
#pragma unroll
            for (int m = 0; m < 4; ++m) { bf16_t* rowp = proj + (size_t)(row0 + ai * 128 + m * 16) * DM + col0;
#pragma unroll
                for (int bj = 0; bj < 2; ++bj) { const f32x4 v0 = g[bj][0] * acc[ai][bj][m][0], v1 = g[bj][1] * acc[ai][bj][m][1];
                    u32x4 w; w.x = cvt_pk_bf16(v0[0], v0[1]); w.y = cvt_pk_bf16(v0[2], v0[3]); w.z = cvt_pk_bf16(v1[0], v1[1]); w.w = cvt_pk_bf16(v1[2], v1[3]);
                    *(u32x4*)(rowp + bj * 128) = w; } }
    }
};

#include <hip/hip_bf16.h>
#include <cmath>
namespace attn_body {
using bf16=__hip_bfloat16;
using bf16x8=__attribute__((ext_vector_type(8)))short;
using s16x4=__attribute__((ext_vector_type(4)))short;
using f32x16=__attribute__((ext_vector_type(16)))float;
using u32x4=__attribute__((ext_vector_type(4)))unsigned;
constexpr int D=64,QP=512,KVP=128,OP=1024,SQ=2048,SK=2304;
constexpr int NW=8,QBLK=32,QB=QBLK*NW,KVBLK=64,NQB=SQ/QB;
constexpr int ATTN_UNIT_ROWS=QB;
__device__ __forceinline__ int crow(int r,int hi){return (r&3)+8*(r>>2)+4*hi;}
#define SBAR() __builtin_amdgcn_sched_barrier(0)
__device__ __forceinline__ void cmask(f32x16&p0,f32x16&p1,int jb,int qrel,int hi){
  const float NEG=-INFINITY; int kb=64*jb+4*hi;
  #pragma unroll
  for(int r=0;r<16;++r){int kv=kb+(r&3)+8*(r>>2); if(kv>qrel)p0[r]=NEG; if(kv+32>qrel)p1[r]=NEG;}
}

constexpr int NSLOT=3, SLOTB=8192;
constexpr int LDS_K=0, LDS_V=NSLOT*SLOTB, LDS_WS=2*NSLOT*SLOTB, LDS_OST=LDS_WS+NW*64*4, LDS_BYTES=LDS_OST+NW*4096;
constexpr float C2=0.125f*1.4426950408889634f;
__device__ __forceinline__ void glds16(const void*gsrc,unsigned lds_dst){unsigned keep;
  asm volatile("s_mov_b32 %0, m0\n\ts_mov_b32 m0, %2\n\ts_nop 0\n\tglobal_load_lds_dwordx4 %1, off\n\ts_mov_b32 m0, %0":"=&s"(keep):"v"(gsrc),"s"(lds_dst):"memory");}
__device__ __forceinline__ float max3f(float a,float b,float c){float r;asm("v_max3_f32 %0, %1, %2, %3":"=v"(r):"v"(a),"v"(b),"v"(c));return r;}
__device__ __forceinline__ float max2f(float a,float b){float r;asm("v_max_f32_e32 %0, %1, %2":"=v"(r):"v"(a),"v"(b));return r;}
__device__ __forceinline__ float fadd_s(float a,float b){float r;asm("v_add_f32_e32 %0, %1, %2":"=v"(r):"v"(a),"v"(b));return r;}
__device__ __forceinline__ float fsub_s(float a,float b){float r;asm("v_sub_f32_e32 %0, %1, %2":"=v"(r):"v"(a),"v"(b));return r;}
typedef float f32x2_t __attribute__((ext_vector_type(2))); typedef __bf16 bf16x2_t __attribute__((ext_vector_type(2)));
__device__ __forceinline__ unsigned cvtpk_s(float lo,float hi){f32x2_t v={lo,hi};bf16x2_t b=__builtin_convertvector(v,bf16x2_t);return __builtin_bit_cast(unsigned,b);}
#define WAIT_BAR(N) asm volatile("s_waitcnt vmcnt(" #N ") lgkmcnt(0)\n\ts_barrier":::"memory")

__device__ __forceinline__ void qkt(f32x16&p0,f32x16&p1,const char*Kslot,const bf16x8*qr,const f32x16&negm,int r32,int hi){
  const char*kb=Kslot+hi*1024+r32*16;
  #pragma unroll
  for(int d0=0;d0<4;++d0){
    const bf16x8 b0=*reinterpret_cast<const bf16x8*>(kb+d0*2048);
    const bf16x8 b1=*reinterpret_cast<const bf16x8*>(kb+d0*2048+512);
    if(d0==0){p0=__builtin_amdgcn_mfma_f32_32x32x16_bf16(b0,qr[0],negm,0,0,0);p1=__builtin_amdgcn_mfma_f32_32x32x16_bf16(b1,qr[0],negm,0,0,0);}
    else{p0=__builtin_amdgcn_mfma_f32_32x32x16_bf16(b0,qr[d0],p0,0,0,0);p1=__builtin_amdgcn_mfma_f32_32x32x16_bf16(b1,qr[d0],p1,0,0,0);}}
}
typedef __attribute__((address_space(3))) const char* lds_cptr;
typedef short v4i16_t __attribute__((ext_vector_type(4)));
__device__ __forceinline__ void kload8(bf16x8*kf,lds_cptr kp){
  kf[0]=*(const __attribute__((address_space(3))) bf16x8*)(kp);      kf[1]=*(const __attribute__((address_space(3))) bf16x8*)(kp+512);
  kf[2]=*(const __attribute__((address_space(3))) bf16x8*)(kp+2048); kf[3]=*(const __attribute__((address_space(3))) bf16x8*)(kp+2560);
  kf[4]=*(const __attribute__((address_space(3))) bf16x8*)(kp+4096); kf[5]=*(const __attribute__((address_space(3))) bf16x8*)(kp+4608);
  kf[6]=*(const __attribute__((address_space(3))) bf16x8*)(kp+6144); kf[7]=*(const __attribute__((address_space(3))) bf16x8*)(kp+6656);
}
__device__ __forceinline__ void kload2(bf16x8*kf,lds_cptr kp,int j){ kf[2*j]=*(const __attribute__((address_space(3))) bf16x8*)(kp+j*2048); kf[2*j+1]=*(const __attribute__((address_space(3))) bf16x8*)(kp+j*2048+512); }
__device__ __forceinline__ s16x4 vtr(lds_cptr p){ return __builtin_bit_cast(s16x4,__builtin_amdgcn_ds_read_tr16_b64_v4i16((__attribute__((address_space(3))) v4i16_t*)p)); }
__device__ __forceinline__ float rowmax(const f32x16&p0,const f32x16&p1){
  float a=max3f(p0[0],p0[1],p1[0]),b=max3f(p0[2],p0[3],p1[1]);a=max3f(a,p1[2],p1[3]);
  #pragma unroll
  for(int r=4;r<16;r+=4){a=max3f(a,p0[r],p0[r+1]);b=max3f(b,p0[r+2],p0[r+3]);a=max3f(a,p1[r],p1[r+1]);b=max3f(b,p1[r+2],p1[r+3]);}
  const float m=max2f(a,b);
  auto rr=__builtin_amdgcn_permlane32_swap(__float_as_uint(m),__float_as_uint(m),false,false);
  return max2f(__uint_as_float(rr[0]),__uint_as_float(rr[1]));
}
__device__ __forceinline__ void pv(f32x16*o,int vb,bf16x8 pa0,bf16x8 pa1,bf16x8 pa2,bf16x8 pa3){
  #pragma unroll
  for(int d0=0;d0<2;++d0){s16x4 lo[4],hi[4];
    #pragma unroll
    for(int ks=0;ks<4;++ks){
      asm volatile("ds_read_b64_tr_b16 %0,%1 offset:%c2":"=&v"(lo[ks]):"v"(vb),"i"(d0*4096+ks*1024):"memory");
      asm volatile("ds_read_b64_tr_b16 %0,%1 offset:%c2":"=&v"(hi[ks]):"v"(vb),"i"(d0*4096+ks*1024+512):"memory");}
    asm volatile("s_waitcnt lgkmcnt(0)":::"memory");SBAR();
    #define PK(k) (bf16x8){lo[k][0],lo[k][1],lo[k][2],lo[k][3],hi[k][0],hi[k][1],hi[k][2],hi[k][3]}
    o[d0]=__builtin_amdgcn_mfma_f32_32x32x16_bf16(pa0,PK(0),o[d0],0,0,0);
    o[d0]=__builtin_amdgcn_mfma_f32_32x32x16_bf16(pa1,PK(1),o[d0],0,0,0);
    o[d0]=__builtin_amdgcn_mfma_f32_32x32x16_bf16(pa2,PK(2),o[d0],0,0,0);
    o[d0]=__builtin_amdgcn_mfma_f32_32x32x16_bf16(pa3,PK(3),o[d0],0,0,0);
    #undef PK
  }
}

#ifndef ATTN_STORE16
#define ATTN_STORE16(p,v) (*(u32x4*)(p)=(v))
#endif
template<int THRL> __device__ __forceinline__ void attn_unit(int b,int h,int qb,const bf16*Q,const bf16*__restrict__ K,const bf16*__restrict__ V,bf16*O,char*shm){
  const int tid=threadIdx.x,lane=tid&63,r32=lane&31,hi=lane>>5; const int wid=__builtin_amdgcn_readfirstlane(tid>>6);
  const long rowbase=(long)b*SQ; const int q0=qb*QB; const int kvh=h>>2;
  const bf16*Qw=Q+(rowbase+q0+wid*QBLK)*QP+h*D;
  const bf16*Kh=K+(long)b*SK*KVP+kvh*D,*Vh=V+(long)b*SK*KVP+kvh*D;
  const unsigned lds0=(unsigned)(uintptr_t)shm;
  float*wsf=(float*)(shm+LDS_WS)+wid*64;
  const bf16*ksrc=Kh+(long)lane*KVP+wid*8;
  const bf16*vsrc=Vh+(long)(16*(wid&3)+(lane>>2))*KVP+(wid>>2)*32+(lane&3)*8;
  const unsigned kdst=lds0+LDS_K+wid*1024, vdst=lds0+LDS_V+wid*1024;
  #define DMA_K(t,slot) glds16(ksrc+(long)(t)*KVBLK*KVP,(unsigned)__builtin_amdgcn_readfirstlane(kdst+(slot)))
  #define DMA_V(t,slot) glds16(vsrc+(long)(t)*KVBLK*KVP,(unsigned)__builtin_amdgcn_readfirstlane(vdst+(slot)))
  const int vb0=(int)(lds0+LDS_V)+((lane>>4)&1)*32+(lane&3)*8+(4*hi+((lane&15)>>2))*64;
  const char*Kbase=shm+LDS_K; bf16x8 kf[8];
  const lds_cptr shm3=(lds_cptr)shm; const lds_cptr kp0=shm3+LDS_K+hi*1024+r32*16; const lds_cptr vp0=shm3+LDS_V+((lane>>4)&1)*32+(lane&3)*8+(4*hi+((lane&15)>>2))*64;
  constexpr int NT=SK/KVBLK;
  DMA_K(0,0);DMA_V(0,0);DMA_K(1,SLOTB);
  bf16x8 qr[4];
  #pragma unroll
  for(int d0=0;d0<4;++d0)qr[d0]=*reinterpret_cast<const bf16x8*>(&Qw[(long)r32*QP+d0*16+hi*8]);
  float mhat=0.f,l_reg=0.f;f32x16 o[2];o[0]=f32x16{};o[1]=f32x16{};f32x16 negm=f32x16{};asm volatile("":"+v"(negm));
  #define CMASK(P0,P1,t) do{}while(0)
  bool resc=false;
  #define START(P0,P1) do{ const float rm=rowmax(P0,P1); resc=false; \
    { const float dl=rm; mhat=fadd_s(mhat,dl); \
      _Pragma("unroll") for(int r=0;r<16;++r){P0[r]=fsub_s(P0[r],dl);P1[r]=fsub_s(P1[r],dl);} \
      _Pragma("unroll") for(int r=0;r<16;++r)negm[r]=-mhat; asm volatile("":"+v"(negm)); } \
    _Pragma("unroll") for(int r=0;r<16;++r)P0[r]=__builtin_amdgcn_exp2f(P0[r]); }while(0)
  #define RESC() do{ if(resc){ asm volatile("s_waitcnt lgkmcnt(0)":::"memory"); \
      _Pragma("unroll") for(int d_=0;d_<2;++d_) _Pragma("unroll") for(int r=0;r<16;++r)o[d_][r]*=wsf[crow(r,hi)]; } }while(0)
  f32x16 pA0,pA1,pB0,pB1;
  int sl_prev=0,sl_cur=0,sl_next=SLOTB;
  #define ROT() do{sl_prev=sl_cur;sl_cur=sl_next;sl_next=(sl_next==(NSLOT-1)*SLOTB)?0:sl_next+SLOTB;}while(0)
  DMA_K(2,2*SLOTB);
  WAIT_BAR(3);
  qkt(pA0,pA1,Kbase,qr,negm,r32,hi);asm volatile("s_nop 15\n\ts_nop 7":"+v"(pA0),"+v"(pA1));CMASK(pA0,pA1,0);
  START(pA0,pA1);
  _Pragma("unroll") for(int r=0;r<16;++r)pA1[r]=__builtin_amdgcn_exp2f(pA1[r]);
  WAIT_BAR(0);
  DMA_K(3,0);DMA_V(1,SLOTB);
  ROT();
  kload8(kf,kp0+sl_cur);
  WAIT_BAR(2);
  s16x4 vlo[8],vhi[8]; u32x4 pw0,pw1,pw2,pw3;
  #define PKW(P,B) cvtpk_s(P[B],P[B+1])
  #define PAF(k) __builtin_bit_cast(bf16x8,pw##k)
  #define VFR(i) (bf16x8){vlo[i][0],vlo[i][1],vlo[i][2],vlo[i][3],vhi[i][0],vhi[i][1],vhi[i][2],vhi[i][3]}
  #define PIN(x) asm volatile("":"+v"(x))
  #define MX3(a,b,c) __builtin_fmaxf(__builtin_fmaxf((a),(b)),(c))
  #define GAPA(MF,A0,A1,A2,A3,W0,W1,PW) do{ MF; sacc+=A0; sacc+=A1; sacc+=A2; sacc+=A3; PIN(sacc); W0; W1; PIN(PW); SBAR(); }while(0)
  #define EX(v) __builtin_amdgcn_exp2f(v)
  #define GAPB(MF,X,B) do{ MF; X[B]=EX(X[B]); X[B+1]=EX(X[B+1]); X[B+2]=EX(X[B+2]); X[B+3]=EX(X[B+3]); PIN(X); SBAR(); }while(0)
  #define VRD(i) do{ vlo[i]=vtr(vp_+(((i)>>2)*4096+((i)&3)*1024)); vhi[i]=vtr(vp_+(((i)>>2)*4096+((i)&3)*1024+512)); }while(0)
  #define KRD(G,j) do{ if(G){ kload2(kf,kp0+sl_next,j); SBAR(); } }while(0)
  #define STEP(C0,C1,P0,P1,t,GK,GV,GL) do{ SBAR(); \
    const lds_cptr vp_=vp0+sl_prev; \
    VRD(0); SBAR(); float sacc=(P0[0]+P0[1]); \
    GAPA(C0=__builtin_amdgcn_mfma_f32_32x32x16_bf16(kf[0],qr[0],negm,0,0,0), P0[2],P0[3],P0[4],P0[5],     pw0[0]=PKW(P0,0), pw0[1]=PKW(P0,2), pw0); \
    VRD(4); SBAR(); GAPA(C1=__builtin_amdgcn_mfma_f32_32x32x16_bf16(kf[1],qr[0],negm,0,0,0), P0[6],P0[7],P0[8],P0[9],     pw0[2]=PKW(P0,4), pw0[3]=PKW(P0,6), pw0); \
    VRD(1); SBAR(); GAPA(C0=__builtin_amdgcn_mfma_f32_32x32x16_bf16(kf[2],qr[1],C0,0,0,0),   P0[10],P0[11],P0[12],P0[13], pw1[0]=PKW(P0,8), pw1[1]=PKW(P0,10), pw1); \
    VRD(5); SBAR(); GAPA(C1=__builtin_amdgcn_mfma_f32_32x32x16_bf16(kf[3],qr[1],C1,0,0,0),   P0[14],P0[15],P1[0],P1[1],   pw1[2]=PKW(P0,12),pw1[3]=PKW(P0,14), pw1); \
    VRD(2); SBAR(); GAPA(C0=__builtin_amdgcn_mfma_f32_32x32x16_bf16(kf[4],qr[2],C0,0,0,0),   P1[2],P1[3],P1[4],P1[5],     pw2[0]=PKW(P1,0), pw2[1]=PKW(P1,2), pw2); \
    VRD(6); SBAR(); GAPA(C1=__builtin_amdgcn_mfma_f32_32x32x16_bf16(kf[5],qr[2],C1,0,0,0),   P1[6],P1[7],P1[8],P1[9],     pw2[2]=PKW(P1,4), pw2[3]=PKW(P1,6), pw2); \
    VRD(3); SBAR(); GAPA(C0=__builtin_amdgcn_mfma_f32_32x32x16_bf16(kf[6],qr[3],C0,0,0,0),   P1[10],P1[11],P1[12],P1[13], pw3[0]=PKW(P1,8), pw3[1]=PKW(P1,10), pw3); \
    VRD(7); SBAR(); GAPA(C1=__builtin_amdgcn_mfma_f32_32x32x16_bf16(kf[7],qr[3],C1,0,0,0),   P1[14],P1[15],0.f,0.f,       pw3[2]=PKW(P1,12),pw3[3]=PKW(P1,14), pw3); \
    l_reg+=sacc; \
    if(GK){DMA_K((t)+3,sl_cur);} if(GV){DMA_V((t)+1,sl_next);} \
    CMASK(C0,C1,t); \
    { float a=MX3(C0[0],C0[1],C1[0]),b=MX3(C0[2],C0[3],C1[1]); a=MX3(a,C1[2],C1[3]); \
      _Pragma("unroll") for(int r=4;r<16;r+=4){a=MX3(a,C0[r],C0[r+1]);b=MX3(b,C0[r+2],C0[r+3]);a=MX3(a,C1[r],C1[r+1]);b=MX3(b,C1[r+2],C1[r+3]);} \
      float rm=__builtin_fmaxf(a,b); { auto rr=__builtin_amdgcn_permlane32_swap(__float_as_uint(rm),__float_as_uint(rm),false,false); rm=__builtin_fmaxf(__uint_as_float(rr[0]),__uint_as_float(rr[1])); } \
      resc=false; \
      if(__builtin_expect(__any(rm>(float)THRL),0)){ const float dl=__builtin_fmaxf(rm,0.f); mhat+=dl; \
        _Pragma("unroll") for(int r=0;r<16;++r){C0[r]-=dl;C1[r]-=dl;} \
        _Pragma("unroll") for(int r=0;r<16;++r)negm[r]=-mhat; asm volatile("":"+v"(negm)); \
        const float f=__builtin_amdgcn_exp2f(-dl); l_reg*=f; if(hi==0)wsf[r32]=f; resc=true; } } \
    SBAR(); \
    GAPB(o[0]=__builtin_amdgcn_mfma_f32_32x32x16_bf16(PAF(0),VFR(0),o[0],0,0,0), C0,0); \
    GAPB(o[1]=__builtin_amdgcn_mfma_f32_32x32x16_bf16(PAF(0),VFR(4),o[1],0,0,0), C0,4); \
    KRD(GL,0); GAPB(o[0]=__builtin_amdgcn_mfma_f32_32x32x16_bf16(PAF(1),VFR(1),o[0],0,0,0), C0,8); \
    KRD(GL,1); GAPB(o[1]=__builtin_amdgcn_mfma_f32_32x32x16_bf16(PAF(1),VFR(5),o[1],0,0,0), C0,12); \
    KRD(GL,2); GAPB(o[0]=__builtin_amdgcn_mfma_f32_32x32x16_bf16(PAF(2),VFR(2),o[0],0,0,0), C1,0); \
    KRD(GL,3); GAPB(o[1]=__builtin_amdgcn_mfma_f32_32x32x16_bf16(PAF(2),VFR(6),o[1],0,0,0), C1,4); \
    GAPB(o[0]=__builtin_amdgcn_mfma_f32_32x32x16_bf16(PAF(3),VFR(3),o[0],0,0,0), C1,8); \
    GAPB(o[1]=__builtin_amdgcn_mfma_f32_32x32x16_bf16(PAF(3),VFR(7),o[1],0,0,0), C1,12); \
    }while(0)
  int t=1;
  #undef CMASK
  #define CMASK(P0,P1,t) do{}while(0)
  for(;t+5<NT;t+=2){
    STEP(pB0,pB1,pA0,pA1,t,true,true,true);     WAIT_BAR(2); RESC(); ROT();
    STEP(pA0,pA1,pB0,pB1,t+1,true,true,true);   WAIT_BAR(2); RESC(); ROT();
  }
  #undef CMASK
  #define CMASK(P0,P1,t) do{}while(0)
  #define ENDW(tt) do{ if((tt)+3<NT){WAIT_BAR(2);} else if((tt)+2<NT){WAIT_BAR(1);} else {WAIT_BAR(0);} }while(0)
  for(;t+1<NT;t+=2){
    STEP(pB0,pB1,pA0,pA1,t,(t+3<NT),(t+1<NT),(t+1<NT));       ENDW(t);   RESC(); ROT();
    STEP(pA0,pA1,pB0,pB1,t+1,(t+4<NT),(t+2<NT),(t+2<NT));     ENDW(t+1); RESC(); ROT();
  }
  STEP(pB0,pB1,pA0,pA1,NT-1,false,false,false); RESC();
  { float sacc=pB0[0]+pB0[1]; _Pragma("unroll") for(int r=2;r<16;++r)sacc+=pB0[r]; _Pragma("unroll") for(int r=0;r<16;++r)sacc+=pB1[r]; l_reg+=sacc;
    pw0=(u32x4){PKW(pB0,0),PKW(pB0,2),PKW(pB0,4),PKW(pB0,6)};pw1=(u32x4){PKW(pB0,8),PKW(pB0,10),PKW(pB0,12),PKW(pB0,14)};pw2=(u32x4){PKW(pB1,0),PKW(pB1,2),PKW(pB1,4),PKW(pB1,6)};pw3=(u32x4){PKW(pB1,8),PKW(pB1,10),PKW(pB1,12),PKW(pB1,14)};
    SBAR(); pv(o,vb0+sl_cur,PAF(0),PAF(1),PAF(2),PAF(3)); }
  #undef PKW
  #undef PAF
  #undef VFR
  #undef PIN
  #undef MX3
  #undef GAPA
  #undef GAPB
  #undef EX
  #undef VRD
  #undef KRD
  #undef STEP
  #undef ENDW
  {auto rr=__builtin_amdgcn_permlane32_swap(__float_as_uint(l_reg),__float_as_uint(l_reg),false,false);l_reg=__uint_as_float(rr[0])+__uint_as_float(rr[1]);}
  if(hi==0)wsf[32+r32]=l_reg;asm volatile("s_waitcnt lgkmcnt(0)":::"memory");
  float rli[16];
  #pragma unroll
  for(int r=0;r<16;++r)rli[r]=__builtin_amdgcn_rcpf(wsf[32+crow(r,hi)]);
  bf16*Ow=O+(rowbase+q0+wid*QBLK)*OP+h*D;
  { bf16*stg=(bf16*)(shm+LDS_OST)+wid*2048;
    #pragma unroll
    for(int r=0;r<16;++r){const int orow=crow(r,hi);
      #pragma unroll
      for(int d0=0;d0<2;++d0)stg[orow*64+d0*32+r32]=__float2bfloat16(o[d0][r]*rli[r]);}
    asm volatile("s_waitcnt lgkmcnt(0)":::"memory");
    #pragma unroll
    for(int i=0;i<4;++i){const int row=i*8+(lane>>3),ch=lane&7; const u32x4 v=*(const u32x4*)(stg+row*64+ch*8); ATTN_STORE16(Ow+(long)row*OP+ch*8,v);} }
  asm volatile("s_waitcnt lgkmcnt(0)\n\ts_barrier":::"memory");
  #undef DMA_K
  #undef DMA_V
  #undef CMASK
  #undef START
  #undef RESC
  #undef ROT
}
constexpr int ATTN_LDS_BYTES=LDS_BYTES;
template<int THRL> __device__ __forceinline__ void attn_unit_L(int L,char*lds,const bf16*Q,const bf16*K,const bf16*V,bf16*O){
  const int xg=(L&255)>>5, rd=L>>8, pair=(4*xg+rd)&31, w=L&31, b=pair>>1, kvh=pair&1, g=w>>3, qb=w&7;
  attn_unit<THRL>(b,kvh*4+g,qb,Q,K,V,O,lds);
}
#undef SBAR
#undef WAIT_BAR
}

typedef GAS unsigned gu32;
typedef GAS unsigned long long gu64;
#define RLX_AGENT __ATOMIC_RELAXED, __HIP_MEMORY_SCOPE_AGENT

#define XB_TMO      128
#define XB_XCNT(j)  (256  + 64 * (j))
#define XB_XSUB(j)  (1280 + 64 * (j))
#define XB_XGEN(j)  (2304 + 64 * (j))
#define XB_TOP      3328
#define XB_TOPGEN   3392
#define XCD_BAR_WORDS 3456
#define XB_SPIN_CAP (1u << 18)

__device__ __forceinline__ unsigned xb_ld(unsigned* p)              { return __hip_atomic_load(p, __ATOMIC_RELAXED, __HIP_MEMORY_SCOPE_AGENT); }
__device__ __forceinline__ unsigned xb_add(unsigned* p, unsigned v) { return __hip_atomic_fetch_add(p, v, __ATOMIC_RELAXED, __HIP_MEMORY_SCOPE_AGENT); }
__device__ __forceinline__ unsigned xb_xcc_id() { return (unsigned)__builtin_amdgcn_s_getreg((3 << 11) | 20) & 0xFu; }
#define XB_SPIN(cond, bar) do { unsigned _sp = 0; while (cond) { __builtin_amdgcn_s_sleep(1); \
    if ((++_sp & 255u) == 0u) { if (xb_ld(&(bar)[XB_TMO])) break; if (_sp > XB_SPIN_CAP) { atomicAdd(&(bar)[XB_TMO], 1u); break; } } } } while (0)

struct XcdBarrier {
    unsigned* bar; unsigned x;
    volatile LAS unsigned* st;
};

__device__ __forceinline__ XcdBarrier xcd_barrier_post(unsigned* bar, volatile LAS unsigned* st) {
    XcdBarrier b; b.bar = bar; b.x = xb_xcc_id(); b.st = st;
    if (threadIdx.x == 0) (void)xb_add(&bar[XB_XCNT(b.x)], 1u);
    return b;
}
__device__ __forceinline__ void xcd_barrier_complete(unsigned* bar, unsigned x, unsigned& nloc, unsigned& nx) {
    const unsigned G = gridDim.x * gridDim.y * gridDim.z;
    unsigned sum, cnt, mine, sp = 0u;
    for (;;) {
        sum = 0u; cnt = 0u; mine = 0u;
#pragma unroll
        for (unsigned j = 0; j < 16; ++j) { const unsigned c = xb_ld(&bar[XB_XCNT(j)]); sum += c; cnt += (c > 0u) ? 1u : 0u; mine = (j == x) ? c : mine; }
        if (sum == G) break;
        __builtin_amdgcn_s_sleep(1);
        if ((++sp & 255u) == 0u) { if (xb_ld(&bar[XB_TMO])) break; if (sp > XB_SPIN_CAP) { atomicAdd(&bar[XB_TMO], 1u); break; } }
    }
    nloc = mine > 0u ? mine : 1u; nx = cnt > 0u ? cnt : 1u;
}

__device__ __forceinline__ void xcd_barrier(const XcdBarrier& b) {
    asm volatile("s_waitcnt vmcnt(0)" ::: "memory");
    __syncthreads();
    if (threadIdx.x == 0) {
        unsigned* bar = b.bar;
        __builtin_amdgcn_s_waitcnt(0);
        unsigned nloc = b.st[0], nx = b.st[1];
        if (nloc == 0u) { xcd_barrier_complete(bar, b.x, nloc, nx); b.st[0] = nloc; b.st[1] = nx; }
        const unsigned old = xb_add(&bar[XB_XSUB(b.x)], 1u);
        const unsigned gen = old / nloc;
        if (old + 1u == (gen + 1u) * nloc) {
            __builtin_amdgcn_fence(__ATOMIC_RELEASE, "agent");
            asm volatile("s_waitcnt vmcnt(0)" ::: "memory");
            const unsigned og = xb_add(&bar[XB_TOP], 1u);
            const unsigned tg = og / nx;
            if (og + 1u == (tg + 1u) * nx) xb_add(&bar[XB_TOPGEN], 1u);
            else XB_SPIN(xb_ld(&bar[XB_TOPGEN]) == tg, bar);
            __builtin_amdgcn_fence(__ATOMIC_ACQUIRE, "agent");
            xb_add(&bar[XB_XGEN(b.x)], 1u);
            asm volatile("s_waitcnt vmcnt(0)" ::: "memory");
        } else {
            XB_SPIN(xb_ld(&bar[XB_XGEN(b.x)]) == gen, bar);
            __builtin_amdgcn_fence(__ATOMIC_ACQUIRE, "agent");
            asm volatile("s_waitcnt vmcnt(0)" ::: "memory");
        }
    }
    __syncthreads();
}

constexpr int NWAVES = 8, NTHREADS = NWAVES * 64;
constexpr int LDS_BYTES = 160 * 1024;
#define LDS_WAIT() asm volatile("s_waitcnt lgkmcnt(0)" ::: "memory")
#define VM_WAIT() asm volatile("s_waitcnt vmcnt(0)" ::: "memory")

struct Frame {
    LAS unsigned char* lds;
    int tid, lane, wave, G, bx;
    Params p;
};

__device__ __forceinline__ void p0_adaln(Frame& F) {
    LAS float* st = (LAS float*)F.lds;
    LAS float* red = (LAS float*)(F.lds + 1024 * 20 * 4);
    const Params& p = F.p;
    for (int k = F.tid; k < DM; k += NTHREADS) {
#pragma unroll
        for (int r = 0; r < 17; ++r) { const float c = (r < 16) ? p.c[r * DM + k] : p.c_ctx[k]; st[k * 20 + r] = silu_f(c); }
    }
    __syncthreads();
    const int col = F.lane & 15, kq = F.lane >> 4;
    for (int item = F.bx; item < 6144 / 16; item += F.G) {
        const int n0 = item * 16;
        float acc[17];
#pragma unroll
        for (int r = 0; r < 17; ++r) acc[r] = 0.f;
        const float* wp = p.w_mod + (size_t)(F.wave * 128 + kq) * 6144 + n0 + col;
#pragma unroll 8
        for (int it = 0; it < 32; ++it) {
            const float w = __builtin_nontemporal_load(wp + (size_t)it * 4 * 6144);
            const LAS float* sr = st + (F.wave * 128 + it * 4 + kq) * 20;
            const f32x4 s0 = *(const LAS f32x4*)(sr), s1 = *(const LAS f32x4*)(sr + 4), s2 = *(const LAS f32x4*)(sr + 8), s3 = *(const LAS f32x4*)(sr + 12); const float s4 = sr[16];
            acc[0] += s0[0] * w; acc[1] += s0[1] * w; acc[2] += s0[2] * w; acc[3] += s0[3] * w;
            acc[4] += s1[0] * w; acc[5] += s1[1] * w; acc[6] += s1[2] * w; acc[7] += s1[3] * w;
            acc[8] += s2[0] * w; acc[9] += s2[1] * w; acc[10] += s2[2] * w; acc[11] += s2[3] * w;
            acc[12] += s3[0] * w; acc[13] += s3[1] * w; acc[14] += s3[2] * w; acc[15] += s3[3] * w; acc[16] += s4 * w;
        }
#pragma unroll
        for (int r = 0; r < 17; ++r) { acc[r] += __shfl_xor(acc[r], 16); acc[r] += __shfl_xor(acc[r], 32); }
        if (kq == 0) {
#pragma unroll
            for (int r = 0; r < 17; ++r) red[(F.wave * 17 + r) * 16 + col] = acc[r];
        }
        __syncthreads();
        if (F.tid < 17 * 16) { const int r = F.tid >> 4, c = F.tid & 15; float s = 0.f;
#pragma unroll
            for (int w = 0; w < 8; ++w) s += red[(w * 17 + r) * 16 + c];
            ((float*)(p.ws + WS_MOD))[r * 6144 + n0 + c] = s + p.b_mod[n0 + c]; }
        __syncthreads();
    }
}
__device__ __forceinline__ void p0_transpose_item(const float* W, int N, bf16_t* WT, int K, int k0, int n0, int row_t0, LAS float* scr, int lane) {
    const float* src = W + (size_t)(k0 + (lane >> 5)) * N + n0 + (lane & 31);
    float v[32];
#pragma unroll
    for (int i = 0; i < 32; ++i) v[i] = __builtin_nontemporal_load(src + (size_t)(2 * i) * N);
#pragma unroll
    for (int i = 0; i < 32; ++i) scr[(2 * i + (lane >> 5)) * 33 + (lane & 31)] = v[i];
    LDS_WAIT(); asm volatile("" ::: "memory");
    const int c = lane & 7;
#pragma unroll
    for (int j = 0; j < 4; ++j) { const int n = (lane >> 3) + 8 * j; const LAS float* s = scr + (8 * c) * 33 + n;
        u32x4 o; o.x = cvt_pk_bf16(s[0 * 33], s[1 * 33]); o.y = cvt_pk_bf16(s[2 * 33], s[3 * 33]); o.z = cvt_pk_bf16(s[4 * 33], s[5 * 33]); o.w = cvt_pk_bf16(s[6 * 33], s[7 * 33]);
        *(u32x4*)(WT + (size_t)(row_t0 + n) * K + k0 + 8 * c) = o; }
    LDS_WAIT(); asm volatile("" ::: "memory");
}
__device__ __forceinline__ void p0_transpose_item_fp8(const float* W, int N, unsigned char* WT, int K, int k0, int n0, int row_t0, LAS float* scr, int lane) {
    const float* src = W + (size_t)(k0 + (lane >> 5)) * N + n0 + (lane & 31);
    float v[64];
#pragma unroll
    for (int i = 0; i < 64; ++i) v[i] = __builtin_nontemporal_load(src + (size_t)(2 * i) * N);
#pragma unroll
    for (int i = 0; i < 64; ++i) scr[(2 * i + (lane >> 5)) * 33 + (lane & 31)] = v[i];
    LDS_WAIT(); asm volatile("" ::: "memory");
    const int c = lane & 7;
#pragma unroll
    for (int j = 0; j < 4; ++j) { const int n = (lane >> 3) + 8 * j; const LAS float* s = scr + (16 * c) * 33 + n;
        u32x4 o;
        o.x = pk4_fp8(s[0 * 33], s[1 * 33], s[2 * 33], s[3 * 33], W8_SCALE); o.y = pk4_fp8(s[4 * 33], s[5 * 33], s[6 * 33], s[7 * 33], W8_SCALE);
        o.z = pk4_fp8(s[8 * 33], s[9 * 33], s[10 * 33], s[11 * 33], W8_SCALE); o.w = pk4_fp8(s[12 * 33], s[13 * 33], s[14 * 33], s[15 * 33], W8_SCALE);
        __builtin_nontemporal_store(o, (u32x4*)(WT + (size_t)(row_t0 + n) * K + k0 + 16 * c)); }
    LDS_WAIT(); asm volatile("" ::: "memory");
}
__device__ __forceinline__ void convert_experts(Frame& F, int lo, int hi, int worker, int nworkers) {
    const Params& p = F.p;
    __syncthreads();
    LAS float* scr = (LAS float*)(F.lds + F.wave * 16896);
    constexpr int I_E = (DM / 128) * (FF / 32);
    unsigned char* w13_t = p.ws + WS_W13_T; unsigned char* w2_t = p.ws + WS_W2_T;
    for (int it = lo + worker; it < hi; it += nworkers) {
        int r = it;
        const int e = r / (3 * I_E); r -= e * 3 * I_E; const int which = r / I_E; r -= which * I_E;
        if (which < 2) { const int nblk = FF / 32, kb = r / nblk, nb = r % nblk, n0 = nb * 32, rt = 256 * (n0 >> 7) + 128 * which + (n0 & 127);
            p0_transpose_item_fp8((which ? p.w3 : p.w1) + (size_t)e * DM * FF, FF, w13_t + (size_t)e * 2 * FF * DM, DM, kb * 128, n0, rt, scr, F.lane); }
        else { const int nblk = DM / 32, kb = r / nblk, nb = r % nblk;
            p0_transpose_item_fp8(p.w2 + (size_t)e * FF * DM, DM, w2_t + (size_t)e * DM * FF, FF, kb * 128, nb * 32, nb * 32, scr, F.lane); }
    }
    __syncthreads();
}
constexpr int CONV_NIT = NE * 3 * (DM / 128) * (FF / 32);
constexpr int CONV_EARLY = 5376;
__device__ __forceinline__ void p0_convert(Frame& F) {
    const Params& p = F.p;
    __syncthreads();
    LAS float* scr = (LAS float*)(F.lds + F.wave * 16896);
    const int gw = F.bx * NWAVES + F.wave, NGW = F.G * NWAVES;
    constexpr int I_IN = (DM / 64) * (DIN / 32), I_OUT = (DM / 64) * (DM / 32);
    bf16_t* win_t = (bf16_t*)(p.ws + WS_WIN_T); bf16_t* wout_t = (bf16_t*)(p.ws + WS_WOUT_T);
    for (int it = gw; it < I_IN + I_OUT; it += NGW) {
        int r = it;
        if (r < I_IN) { const int nblk = DIN / 32, kb = r / nblk, nb = r % nblk, n0 = nb * 32, T = n0 >> 8; int rt = n0;
            if (T < 3) { const int loc = n0 & 255, wc = loc >> 6, bj = (loc >> 5) & 1; rt = 256 * T + 128 * bj + 32 * wc; }
            p0_transpose_item(p.w_in, DIN, win_t, DM, kb * 64, n0, rt, scr, F.lane); continue; }
        r -= I_IN;
        { const int nblk = DM / 32, kb = r / nblk, nb = r % nblk; p0_transpose_item(p.w_out, DM, wout_t, DM, kb * 64, nb * 32, nb * 32, scr, F.lane); }
    }
    const int gt = F.bx * NTHREADS + F.tid, NGT = F.G * NTHREADS;
    for (int i = gt; i < NGRP * CHUNK * CHUNK / 2; i += NGT) { const f32x2 v = *(const f32x2*)(p.w_s + 2 * i); ((unsigned*)(p.ws + WS_WS_B))[i] = cvt_pk_bf16(v[0], v[1]); }
    for (int idx = gt; idx < 2048 * 32; idx += NGT) {
        const int t = idx >> 5, i = idx & 31, f = i & 15;
        const float inv = exp2f(-(float)f * (13.287712379549449f / 16.f));
        const float pos = (i < 16) ? (float)(t >> 6) : (float)(t & 63);
        const float ang = pos * inv;
        float* cs = (float*)(p.ws + WS_ROPE);
        cs[idx] = cosf(ang); cs[2048 * 32 + idx] = sinf(ang);
    }
}
template <int CTRL> __device__ __forceinline__ float dpp_mov(float v) { return __uint_as_float((unsigned)__builtin_amdgcn_mov_dpp((int)__float_as_uint(v), CTRL, 0xF, 0xF, true)); }
constexpr int DPP_XOR1 = 0xB1  , DPP_XOR2 = 0x4E  , DPP_HMIRROR = 0x141  , DPP_MIRROR = 0x140  ;
__device__ __forceinline__ float swap16_sum(float x, float y) { auto rr = __builtin_amdgcn_permlane16_swap(__float_as_uint(x), __float_as_uint(y), false, false); return __uint_as_float(rr[0]) + __uint_as_float(rr[1]); }
__device__ __forceinline__ float swap32_sum(float x, float y) { auto rr = __builtin_amdgcn_permlane32_swap(__float_as_uint(x), __float_as_uint(y), false, false); return __uint_as_float(rr[0]) + __uint_as_float(rr[1]); }
__device__ __forceinline__ float swap16_max(float x) { auto rr = __builtin_amdgcn_permlane16_swap(__float_as_uint(x), __float_as_uint(x), false, false); return fmaxf(__uint_as_float(rr[0]), __uint_as_float(rr[1])); }
__device__ __forceinline__ float swap32_max(float x) { auto rr = __builtin_amdgcn_permlane32_swap(__float_as_uint(x), __float_as_uint(x), false, false); return fmaxf(__uint_as_float(rr[0]), __uint_as_float(rr[1])); }
__device__ __forceinline__ float wave_sum(float v) {
    v += dpp_mov<DPP_XOR1>(v); v += dpp_mov<DPP_XOR2>(v); v += dpp_mov<DPP_HMIRROR>(v); v += dpp_mov<DPP_MIRROR>(v);
    v = swap16_sum(v, v); return swap32_sum(v, v);
}
__device__ __forceinline__ void p1_modulate(Frame& F) {
    const Params& p = F.p;
    const int gw = F.bx * NWAVES + F.wave, NGW = F.G * NWAVES;
    const float* modb = (const float*)(p.ws + WS_MOD);
    for (int pr = gw; pr < MALL / 4; pr += NGW) {
        const int row0 = 4 * pr;
        const float* xr; const float* mod;
        if (row0 < MLAT) { xr = p.x + (size_t)row0 * DM; mod = modb + (row0 >> 11) * 6144; } else { xr = p.ctx + (size_t)(row0 - MLAT) * DM; mod = modb + 16 * 6144; }
        f32x4 v[4][4];
#pragma unroll
        for (int r = 0; r < 4; ++r)
#pragma unroll
            for (int j = 0; j < 4; ++j) v[r][j] = __builtin_nontemporal_load((const f32x4*)(xr + (size_t)r * DM + 4 * F.lane + 256 * j));
        f32x4 gs[4], sh[4];
#pragma unroll
        for (int j = 0; j < 4; ++j) { const int k = 4 * F.lane + 256 * j; gs[j] = *(const f32x4*)(p.g_mix + k) * (*(const f32x4*)(mod + 1024 + k) + 1.f); sh[j] = *(const f32x4*)(mod + k); }
#pragma unroll
        for (int r = 0; r < 4; ++r) { float ss = 0.f;
#pragma unroll
            for (int j = 0; j < 4; ++j) ss += (v[r][j][0] * v[r][j][0] + v[r][j][1] * v[r][j][1]) + (v[r][j][2] * v[r][j][2] + v[r][j][3] * v[r][j][3]);
            const float rstd = rsqrtf(wave_sum(ss) * (1.f / DM) + EPS);
            bf16_t* o = (bf16_t*)(p.ws + WS_XN) + (size_t)(row0 + r) * DM;
#pragma unroll
            for (int j = 0; j < 4; ++j) { const f32x4 h = v[r][j] * rstd * gs[j] + sh[j];
                u32x2 w; w.x = cvt_pk_bf16(h[0], h[1]); w.y = cvt_pk_bf16(h[2], h[3]); *(u32x2*)(o + 4 * F.lane + 256 * j) = w; } }
    }
}

constexpr int SGU_PITCH = 272;
constexpr int SGU_WAVE_BYTES = 64 * SGU_PITCH + 512;
__device__ __forceinline__ void p3_sgu(Frame& F) {
    const Params& p = F.p;
    LAS unsigned char* my = F.lds + F.wave * SGU_WAVE_BYTES;
    LAS float* rs = (LAS float*)(my + 64 * SGU_PITCH);
    const int g = F.wave, lane = F.lane, fr = lane & 15, fq = lane >> 4;
    const bf16_t* VV = (const bf16_t*)(p.ws + WS_VV); const bf16_t* U = (const bf16_t*)(p.ws + WS_U); const float* VSS = (const float*)(p.ws + WS_VSS);
    const bf16_t* WSB = (const bf16_t*)(p.ws + WS_WS_B) + (size_t)g * CHUNK * CHUNK;
    bf16_t* MIXo = (bf16_t*)(p.ws + WS_MIX);
    __syncthreads();
    for (int unit = F.bx; unit < MLAT / CHUNK; unit += F.G) {
        const int r0 = unit * CHUNK;
#pragma unroll
        for (int h = 0; h < 2; ++h) { const int j = lane + 64 * h; const f32x4 a = *(const f32x4*)(VSS + (size_t)(r0 + j) * 8), b = *(const f32x4*)(VSS + (size_t)(r0 + j) * 8 + 4);
            const float ss = ((a[0] + a[1]) + (a[2] + a[3])) + ((b[0] + b[1]) + (b[2] + b[3])); rs[j] = rsqrtf(ss * (1.f / DGM) + EPS); }
        LDS_WAIT();
        { const float s0 = rs[2 * lane], s1 = rs[2 * lane + 1];
          const bf16_t* src = VV + (size_t)(r0 + 2 * lane) * DGM + g * 64;
#pragma unroll
          for (int ch = 0; ch < 8; ++ch) { const u32x4 a = *(const u32x4*)(src + 8 * ch), b = *(const u32x4*)(src + DGM + 8 * ch);
#pragma unroll
              for (int q = 0; q < 4; ++q) { const unsigned ua = a[q], ub = b[q];
                  const float a0 = __uint_as_float(ua << 16) * s0, a1 = __uint_as_float(ua & 0xffff0000u) * s0, b0 = __uint_as_float(ub << 16) * s1, b1 = __uint_as_float(ub & 0xffff0000u) * s1;
                  *(LAS unsigned*)(my + (8 * ch + 2 * q) * SGU_PITCH + 4 * lane) = cvt_pk_bf16(a0, b0);
                  *(LAS unsigned*)(my + (8 * ch + 2 * q + 1) * SGU_PITCH + 4 * lane) = cvt_pk_bf16(a1, b1); } } }
        LDS_WAIT(); asm volatile("" ::: "memory");
#pragma unroll 1
        for (int ih = 0; ih < 2; ++ih) {
            bf16x8 bw[4][4]; u32x2 uu[4][4];
#pragma unroll
            for (int ks = 0; ks < 4; ++ks)
#pragma unroll
                for (int jf = 0; jf < 4; ++jf) bw[ks][jf] = *(const bf16x8*)(WSB + (size_t)(64 * ih + 16 * jf + fr) * CHUNK + 32 * ks + 8 * fq);
#pragma unroll
            for (int jf = 0; jf < 4; ++jf)
#pragma unroll
                for (int df = 0; df < 4; ++df) uu[jf][df] = *(const u32x2*)(U + (size_t)(r0 + 64 * ih + 16 * jf + fr) * DGM + g * 64 + 16 * df + 4 * fq);
            f32x4 acc[4][4];
#pragma unroll
            for (int df = 0; df < 4; ++df)
#pragma unroll
                for (int jf = 0; jf < 4; ++jf) acc[df][jf] = (f32x4){0.f, 0.f, 0.f, 0.f};
#pragma unroll
            for (int ks = 0; ks < 4; ++ks) {
                bf16x8 af[4];
#pragma unroll
                for (int df = 0; df < 4; ++df) af[df] = *(const LAS bf16x8*)(my + (16 * df + fr) * SGU_PITCH + 64 * ks + 16 * fq);
#pragma unroll
                for (int df = 0; df < 4; ++df)
#pragma unroll
                    for (int jf = 0; jf < 4; ++jf) acc[df][jf] = __builtin_amdgcn_mfma_f32_16x16x32_bf16(af[df], bw[ks][jf], acc[df][jf], 0, 0, 0);
            }
#pragma unroll
            for (int jf = 0; jf < 4; ++jf) { const int i = 64 * ih + 16 * jf + fr, row = r0 + i; const float bs = p.b_s[g * CHUNK + i];
#pragma unroll
                for (int df = 0; df < 4; ++df) { const int d = g * 64 + 16 * df + 4 * fq;
                    const f32x4 vg = *(const f32x4*)(p.v_gain + d); const u32x2 uv = uu[jf][df];
                    const f32x4 m = acc[df][jf] * vg + bs;
                    const float u0 = __uint_as_float(uv.x << 16), u1 = __uint_as_float(uv.x & 0xffff0000u), u2 = __uint_as_float(uv.y << 16), u3 = __uint_as_float(uv.y & 0xffff0000u);
                    u32x2 w; w.x = cvt_pk_bf16(u0 * m[0], u1 * m[1]); w.y = cvt_pk_bf16(u2 * m[2], u3 * m[3]);
                    *(u32x2*)(MIXo + (size_t)row * DM + DATT + d) = w; } }
        }
        LDS_WAIT(); asm volatile("" ::: "memory");
    }
}

__device__ __forceinline__ f32x4 x1_ld(const float* x, const bf16_t* proj, size_t off) {
    const f32x4 a = *(const f32x4*)(x + off); const u32x2 b = *(const u32x2*)(proj + off);
    return (f32x4){a[0] + __uint_as_float(b.x << 16), a[1] + __uint_as_float(b.x & 0xffff0000u), a[2] + __uint_as_float(b.y << 16), a[3] + __uint_as_float(b.y & 0xffff0000u)};
}
__device__ __forceinline__ void p5_router(Frame& F) {
    const Params& p = F.p;
    LAS f32x4* wl = (LAS f32x4*)F.lds;
    __syncthreads();
    for (int idx = F.tid; idx < DM * 4; idx += NTHREADS) { const int k = idx >> 2, s = idx & 3;
        wl[(k >> 2) * 17 + ((k & 3) << 2) + s] = *(const f32x4*)(p.w_router + (size_t)k * NE + 4 * s); }
    __syncthreads();
    const int lane = (int)__builtin_amdgcn_mbcnt_hi(~0u, __builtin_amdgcn_mbcnt_lo(~0u, 0u))    ;
    const int gw = F.bx * NWAVES + F.wave, NGW = F.G * NWAVES;
    const float* modb = (const float*)(p.ws + WS_MOD);
    const bf16_t* pj = (const bf16_t*)(p.ws + WS_PROJ); bf16_t* x1b = (bf16_t*)(p.ws + WS_X1B);
    LAS f32x4* xb = (LAS f32x4*)(F.lds + 69632 + F.wave * 8192) + lane;
    float nrstd[2] = {0.f, 0.f};
    if (gw < MLAT / 2) {
#pragma unroll
        for (int r = 0; r < 2; ++r) { float ss = 0.f;
#pragma unroll
            for (int j = 0; j < 4; ++j) { const f32x4 xv = x1_ld(p.x, pj, (size_t)(2 * gw + r) * DM + 4 * lane + 256 * j); xb[(r * 4 + j) * 64] = xv; { u32x2 w; w.x = cvt_pk_bf16(xv[0], xv[1]); w.y = cvt_pk_bf16(xv[2], xv[3]); *(u32x2*)(x1b + (size_t)(2 * gw + r) * DM + 4 * lane + 256 * j) = w; } ss += (xv[0] * xv[0] + xv[1] * xv[1]) + (xv[2] * xv[2] + xv[3] * xv[3]); }
            nrstd[r] = rsqrtf(wave_sum(ss) * (1.f / DM) + EPS); }
    }
    for (int pr = gw; pr < MLAT / 2; pr += NGW) {
        const int row0 = 2 * pr, b = row0 >> 11, t0 = row0 & 2047;
        const float* mod = modb + b * 6144;
        const float rstd[2] = {nrstd[0], nrstd[1]};
        const int prn = (pr + NGW < MLAT / 2) ? pr + NGW : pr;
        f32x4 nx[2][4];
#pragma unroll
        for (int r = 0; r < 2; ++r)
#pragma unroll
            for (int j = 0; j < 4; ++j) nx[r][j] = x1_ld(p.x, pj, (size_t)(2 * prn + r) * DM + 4 * lane + 256 * j);
        float lg[2][16];
#pragma unroll
        for (int r = 0; r < 2; ++r)
#pragma unroll
            for (int e = 0; e < 16; ++e) lg[r][e] = 0.f;
        f32x4 cg = *(const f32x4*)(p.g_ffn + 4 * lane), csc = *(const f32x4*)(mod + 4096 + 4 * lane), csh = *(const f32x4*)(mod + 3072 + 4 * lane);
#pragma unroll 1
        for (int j = 0; j < 4; ++j) {
            const int k = 4 * lane + 256 * j, kn = 4 * lane + 256 * ((j + 1) & 3);
            const f32x4 ng = *(const f32x4*)(p.g_ffn + kn), nsc = *(const f32x4*)(mod + 4096 + kn), nsh = *(const f32x4*)(mod + 3072 + kn);
            const f32x4 cx0 = xb[j * 64], cx1 = xb[(4 + j) * 64];
            f32x4 h[2];
            h[0] = cx0 * rstd[0] * cg * (csc + 1.f) + csh; h[1] = cx1 * rstd[1] * cg * (csc + 1.f) + csh;
#pragma unroll
            for (int r = 0; r < 2; ++r)
                __builtin_nontemporal_store(pk4_fp8(h[r][0], h[r][1], h[r][2], h[r][3], A8_SCALE), (unsigned*)(p.ws + WS_H2 + (size_t)(row0 + r) * DM + k));
            const LAS f32x4* wj = wl + (lane + 64 * j) * 17;
#pragma unroll
            for (int q = 0; q < 4; ++q)
#pragma unroll
                for (int s = 0; s < 4; ++s) { const f32x4 w = wj[4 * q + s];
#pragma unroll
                    for (int r = 0; r < 2; ++r) { const float hv = h[r][q];
                        lg[r][4 * s + 0] += hv * w[0]; lg[r][4 * s + 1] += hv * w[1]; lg[r][4 * s + 2] += hv * w[2]; lg[r][4 * s + 3] += hv * w[3]; } }
            cg = ng; csc = nsc; csh = nsh;
        }
#pragma unroll
        for (int r = 0; r < 2; ++r) {
            float w8[8], w4[4], w2[2], w1;
            const bool b5 = lane & 32, b4 = lane & 16, b3 = lane & 8, b2 = lane & 4;
#pragma unroll
            for (int i = 0; i < 8; ++i) w8[i] = swap32_sum(lg[r][i], lg[r][i + 8]);
#pragma unroll
            for (int i = 0; i < 4; ++i) w4[i] = swap16_sum(w8[i], w8[i + 4]);
#pragma unroll
            for (int i = 0; i < 2; ++i) { const float send = b3 ? w4[i] : w4[i + 2], keep = b3 ? w4[i + 2] : w4[i]; w2[i] = keep + dpp_mov<DPP_MIRROR>(send); }
            { const float send = b2 ? w2[0] : w2[1], keep = b2 ? w2[1] : w2[0]; w1 = keep + dpp_mov<DPP_HMIRROR>(send); }
            w1 += dpp_mov<DPP_XOR2>(w1); w1 += dpp_mov<DPP_XOR1>(w1);
            float mx = w1;
            mx = fmaxf(mx, dpp_mov<DPP_HMIRROR>(mx)); mx = fmaxf(mx, dpp_mov<DPP_MIRROR>(mx)); mx = swap16_max(mx); mx = swap32_max(mx);
            const float ex = __expf(w1 - mx);
            float den = ex;
            den += dpp_mov<DPP_HMIRROR>(den); den += dpp_mov<DPP_MIRROR>(den); den = swap16_sum(den, den); den = swap32_sum(den, den);
            const int e = (b5 ? 8 : 0) + (b4 ? 4 : 0) + (b3 ? 2 : 0) + (b2 ? 1 : 0);
            if ((lane & 3) == 0) ((float*)(p.ws + WS_AFF))[((size_t)b * NE + e) * SEQ + t0 + r] = ex / den;
        }
#pragma unroll
        for (int r = 0; r < 2; ++r) { float ss = 0.f;
#pragma unroll
            for (int j = 0; j < 4; ++j) { xb[(r * 4 + j) * 64] = nx[r][j]; if (prn != pr) { u32x2 w; w.x = cvt_pk_bf16(nx[r][j][0], nx[r][j][1]); w.y = cvt_pk_bf16(nx[r][j][2], nx[r][j][3]); *(u32x2*)(x1b + (size_t)(2 * prn + r) * DM + 4 * lane + 256 * j) = w; } ss += (nx[r][j][0] * nx[r][j][0] + nx[r][j][1] * nx[r][j][1]) + (nx[r][j][2] * nx[r][j][2] + nx[r][j][3] * nx[r][j][3]); }
            nrstd[r] = rsqrtf(wave_sum(ss) * (1.f / DM) + EPS); }
    }
}

__device__ __forceinline__ void p6_topk(Frame& F) {
    const Params& p = F.p;
    LAS unsigned* hist = (LAS unsigned*)F.lds;
    LAS unsigned* sel = hist + 256;
    LAS unsigned* wsum = hist + 264;
    const int tid = F.tid, lane = F.lane;
    for (int be = F.bx; be < NB * NE; be += F.G) {
        const int b = be / NE, e = be % NE;
        const float* aff = (const float*)(p.ws + WS_AFF) + (size_t)be * SEQ;
        const f32x4 v = *(const f32x4*)(aff + 4 * tid);
        unsigned key[4];
#pragma unroll
        for (int i = 0; i < 4; ++i) key[i] = __float_as_uint(v[i]);
        unsigned prefix = 0u, need = CAP;
#pragma unroll
        for (int lvl = 0; lvl < 4; ++lvl) {
            const int sh = 24 - 8 * lvl;
            __syncthreads();
            if (tid < 256) hist[tid] = 0u;
            __syncthreads();
#pragma unroll
            for (int i = 0; i < 4; ++i) { const bool in = (lvl == 0) || ((key[i] >> (sh + 8)) == prefix); if (in) atomicAdd((unsigned*)&hist[(key[i] >> sh) & 255u], 1u); }
            __syncthreads();
            if (tid < 256) { unsigned gt = 0u; for (int j = tid + 1; j < 256; ++j) gt += hist[j];
                const unsigned hme = hist[tid];
                if (gt < need && need <= gt + hme) { sel[0] = (unsigned)tid; sel[1] = need - gt; } }
            __syncthreads();
            prefix = (prefix << 8) | sel[0]; need = sel[1];
        }
        const unsigned T = prefix, need_eq = need;
        unsigned cg_ = 0u, ce_ = 0u;
#pragma unroll
        for (int i = 0; i < 4; ++i) { cg_ += key[i] > T ? 1u : 0u; ce_ += key[i] == T ? 1u : 0u; }
        unsigned pk = cg_ | (ce_ << 16), inc = pk;
#pragma unroll
        for (int o = 1; o < 64; o <<= 1) { const unsigned n = __shfl_up(inc, o); if (lane >= o) inc += n; }
        __syncthreads();
        if (lane == 63) wsum[F.wave] = inc;
        __syncthreads();
        unsigned base = 0u;
        for (int w = 0; w < F.wave; ++w) base += wsum[w];
        unsigned run = base + inc - pk;
        int* idxo = (int*)(p.ws + WS_IDX) + be * CAP; float* gate = (float*)(p.ws + WS_GATE) + (e * NB + b) * CAP; int* inv = (int*)(p.ws + WS_INV);
#pragma unroll
        for (int i = 0; i < 4; ++i) { const int t = 4 * tid + i; const unsigned g_run = run & 0xffffu, e_run = run >> 16;
            const bool isgt = key[i] > T, iseq = key[i] == T;
            const bool take = isgt || (iseq && e_run < need_eq);
            const unsigned pos = g_run + (e_run < need_eq ? e_run : need_eq);
            if (take) { idxo[pos] = t; gate[pos] = v[i]; }
            inv[(size_t)(b * SEQ + t) * NE + e] = take ? (int)((e * NB + b) * CAP + pos) : -1;
            run += (isgt ? 1u : 0u) + (iseq ? 65536u : 0u); }
    }
}

__device__ __forceinline__ void p9_final(Frame& F, float* dst) {
    const Params& p = F.p;
    const int lane = (int)__builtin_amdgcn_mbcnt_hi(~0u, __builtin_amdgcn_mbcnt_lo(~0u, 0u))    , gw = F.bx * NWAVES + F.wave, NGW = F.G * NWAVES;
    const float* modb = (const float*)(p.ws + WS_MOD); const unsigned char* ye = p.ws + WS_YE; const int* invb = (const int*)(p.ws + WS_INV);
    for (int pr = gw; pr < MLAT / 2; pr += NGW) {
        const int row0 = 2 * pr;
        const float* mod = modb + (row0 >> 11) * 6144 + 5120;
        const int sl = invb[(size_t)row0 * NE + (lane & 31)];
        unsigned long long bal = __ballot(sl >= 0);
        unsigned msk[2] = {(unsigned)bal & 0xffffu, ((unsigned)bal >> 16) & 0xffffu};
        f32x4 xv[2][4]; unsigned yw[2][4][4]; float wt[2][4];
#pragma unroll
        for (int r = 0; r < 2; ++r) {
#pragma unroll
            for (int j = 0; j < 4; ++j) { const u32x2 w = *(const u32x2*)((const bf16_t*)(p.ws + WS_X1B) + (size_t)(row0 + r) * DM + 4 * lane + 256 * j);
                xv[r][j] = (f32x4){__uint_as_float(w.x << 16), __uint_as_float(w.x & 0xffff0000u), __uint_as_float(w.y << 16), __uint_as_float(w.y & 0xffff0000u)}; }
#pragma unroll
            for (int q = 0; q < 4; ++q) { int s = 0; wt[r][q] = 0.f;
                if (msk[r]) { const int e = __builtin_ctz(msk[r]); msk[r] &= msk[r] - 1; s = __builtin_amdgcn_readlane(sl, 16 * r + e); wt[r][q] = 1.f / YE8_SCALE; }
                s = __builtin_amdgcn_readfirstlane(s);
                const unsigned char* yr = ye + (size_t)s * DM + 4 * lane;
#pragma unroll
                for (int j = 0; j < 4; ++j) yw[r][q][j] = *(const unsigned*)(yr + 256 * j); }
        }
#pragma unroll
        for (int r = 0; r < 2; ++r) {
            f32x4 m[4];
#pragma unroll
            for (int j = 0; j < 4; ++j) { m[j] = (f32x4){0.f, 0.f, 0.f, 0.f};
#pragma unroll
                for (int q = 0; q < 4; ++q) { const unsigned w = yw[r][q][j]; const float t = wt[r][q];
                    const f32x2 lo = __builtin_amdgcn_cvt_pk_f32_fp8((int)w, false), hi = __builtin_amdgcn_cvt_pk_f32_fp8((int)w, true);
                    m[j][0] += t * lo[0]; m[j][1] += t * lo[1]; m[j][2] += t * hi[0]; m[j][3] += t * hi[1]; } }
            while (msk[r]) {
                const int e = __builtin_ctz(msk[r]); msk[r] &= msk[r] - 1; const int s = __builtin_amdgcn_readlane(sl, 16 * r + e);
                const unsigned char* yr = ye + (size_t)s * DM + 4 * lane;
#pragma unroll
                for (int j = 0; j < 4; ++j) { const unsigned w = *(const unsigned*)(yr + 256 * j);
                    const f32x2 lo = __builtin_amdgcn_cvt_pk_f32_fp8((int)w, false), hi = __builtin_amdgcn_cvt_pk_f32_fp8((int)w, true);
                    m[j][0] += lo[0] * (1.f / YE8_SCALE); m[j][1] += lo[1] * (1.f / YE8_SCALE); m[j][2] += hi[0] * (1.f / YE8_SCALE); m[j][3] += hi[1] * (1.f / YE8_SCALE); } }
            float ss = 0.f; f32x4 v[4];
#pragma unroll
            for (int j = 0; j < 4; ++j) { const int k = 4 * lane + 256 * j; const f32x4 gt = *(const f32x4*)(mod + k);
                v[j] = xv[r][j] + gt * m[j]; ss += (v[j][0] * v[j][0] + v[j][1] * v[j][1]) + (v[j][2] * v[j][2] + v[j][3] * v[j][3]); }
            const float rstd = rsqrtf(wave_sum(ss) * (1.f / DM) + EPS);
            float* xr = dst + (size_t)(row0 + r) * DM;
#pragma unroll
            for (int j = 0; j < 4; ++j) { const int k = 4 * lane + 256 * j; const f32x4 g = *(const f32x4*)(p.g_final + k); __builtin_nontemporal_store(v[j] * rstd * g, (f32x4*)(xr + k)); }
        }
    }
}

#ifndef FFN1_WGM
#define FFN1_WGM 8
#endif
#ifndef FFN2_WGM
#define FFN2_WGM 8
#endif
#ifndef PROBE_REP
#define PROBE_REP -1
#endif
struct Args { Params p; int ph_lo, ph_hi; };
constexpr int N_PHASES = 10;
__global__ void __launch_bounds__(NTHREADS, 2) mk_fwd(Args args) {
    extern __shared__ __attribute__((aligned(16))) unsigned char lds_raw[];
    Frame F;
    F.lds = (LAS unsigned char*)lds_raw;
    F.tid = threadIdx.x; F.lane = F.tid & 63; F.wave = __builtin_amdgcn_readfirstlane(F.tid >> 6);
    F.G = gridDim.x; F.bx = blockIdx.x; F.p = args.p;
    unsigned char* ws = F.p.ws;
    volatile LAS unsigned* bst = (volatile LAS unsigned*)(F.lds + LDS_BYTES - 64);
    if (F.tid < 2) bst[F.tid] = 0u;
    __syncthreads();
    XcdBarrier bar = xcd_barrier_post((unsigned*)ws, bst);
    const int lo = args.ph_lo, hi = args.ph_hi;
#define IN(k) (lo <= (k) && (k) < hi)
#define GSYNC() xcd_barrier(bar)
#define SEAM(k) do { if (IN(k) && IN((k) + 1)) GSYNC(); } while (0)
#define PHASE(k, ...) do { if (IN(k)) { __VA_ARGS__; if (PROBE_REP == (k)) { GSYNC(); __VA_ARGS__; } } SEAM(k); } while (0)
    PHASE(0, p0_adaln(F));
    PHASE(1, { p1_modulate(F); p0_convert(F); });
    PHASE(2, {
        const ProbInProj P{ws}; const EpiInProj E{ws, F.p.q_gain, F.p.k_gain};
        InProjOrder S; S.init(F.G, F.bx);
        pg8::gemm_phase<ProbInProj, EpiInProj, InProjOrder, true>(F.lds, P, S, E);
        { const int nfull = (912 + F.G - 1) / F.G, nidle = nfull * F.G - 912; pg8::Unit ut;
          if (nidle > 0 && !S.next(nfull - 1, ut)) convert_experts(F, 0, CONV_EARLY, (F.bx - (F.G - nidle)) * NWAVES + F.wave, nidle * NWAVES); } });
    PHASE(3, {
        const int vcu = (F.G % 8 == 0) ? (F.bx % 8) * (F.G / 8) + F.bx / 8 : F.bx;
        const int conv_lo = ((912 + F.G - 1) / F.G * F.G - 912) > 0 ? CONV_EARLY : 0;
        const int nun = (1024 - vcu + F.G - 1) / F.G, stagger = ((F.bx >> 3) & 3) < nun ? ((F.bx >> 3) & 3) : nun;
        for (int i = 0; i <= nun; ++i) {
            if (i == stagger) convert_experts(F, conv_lo, CONV_NIT, F.bx * NWAVES + F.wave, F.G * NWAVES);
            if (i < nun) {
                const unsigned char* wsq = ws; asm volatile("" : "+s"(wsq));
                attn_body::attn_unit_L<8>(vcu + i * F.G, (char*)lds_raw, (const attn_body::bf16*)(wsq + WS_Q), (const attn_body::bf16*)(wsq + WS_K), (const attn_body::bf16*)(wsq + WS_V), (attn_body::bf16*)(wsq + WS_MIX));
            }
        }
        p3_sgu(F); });
    PHASE(4, {
        const ProbOutProj P{ws}; const EpiOutProj E{(bf16_t*)(ws + WS_PROJ), (const float*)(ws + WS_MOD)};
        pg8::StaticOrder S; S.init(MLAT, DM, F.G, F.bx);
        pg8::gemm_phase<ProbOutProj, EpiOutProj, pg8::StaticOrder, true>(F.lds, P, S, E); });
    PHASE(5, p5_router(F));
    PHASE(6, p6_topk(F));
    PHASE(7, {
        const ProbFfn1 P{ws}; const EpiFfn1 E{ws + WS_HID};
        pg8::StaticOrder S0; S0.init(NSLOT, 2 * FF, F.G, F.bx, 0, 1 << 30, FFN1_WGM);
        pg8::Unit u0, u1; int i = 0;
        while (S0.next(i, u0)) {
            int j = i + 1; while (S0.next(j, u1) && u1.pm == u0.pm) ++j;
            pg8::StaticOrder S; S.init(NSLOT, 2 * FF, F.G, F.bx, i, j, FFN1_WGM);
            pg8::gemm_phase<ProbFfn1, EpiFfn1, pg8::StaticOrder, true>(F.lds, P, S, E);
            i = j;
        } });
    PHASE(8, {
        const ProbFfn2 P{ws}; const EpiFfn2 E{ws + WS_YE, (const float*)(ws + WS_GATE)};
        pg8::StaticOrder S; S.init(NSLOT, DM, F.G, F.bx, 0, 1 << 30, FFN2_WGM);
        pg8::gemm_phase<ProbFfn2, EpiFfn2, pg8::StaticOrder, true>(F.lds, P, S, E); });
    if (PROBE_REP == 9 && IN(9)) { p9_final(F, (float*)(ws + WS_HID)); GSYNC(); }
    if (PROBE_REP == 10 && IN(9)) { for (int i = 0; i < 8; ++i) GSYNC(); }
    if (IN(9)) p9_final(F, F.p.out);
#undef IN
#undef SEAM
#undef GSYNC
#undef PHASE
}

extern "C" void kernel_launch(void* const* d_in, const int* in_sizes, int n_in, void* d_out, int out_size, void* d_ws, size_t ws_size, hipStream_t stream) {
    if (n_in != 20 || ws_size < WS_END) return;
    static int grid_blocks = 0;
    if (!grid_blocks) {
        int dev = 0, cus = 0, per_cu = 0;
        (void)hipGetDevice(&dev);
        (void)hipDeviceGetAttribute(&cus, hipDeviceAttributeMultiprocessorCount, dev);
        (void)hipFuncSetAttribute((const void*)mk_fwd, hipFuncAttributeMaxDynamicSharedMemorySize, LDS_BYTES);
        (void)hipOccupancyMaxActiveBlocksPerMultiprocessor(&per_cu, (const void*)mk_fwd, NTHREADS, LDS_BYTES);
        grid_blocks = (per_cu >= 1) ? cus : 0;
        if (grid_blocks <= 0) grid_blocks = -1;
    }
    if (grid_blocks < 0) return;
    Args a{};
    const float** f = (const float**)&a.p;
    for (int i = 0; i < 20; ++i) f[i] = (const float*)d_in[i];
    a.p.out = (float*)d_out; a.p.ws = (unsigned char*)d_ws;
    a.ph_lo = 0; a.ph_hi = N_PHASES;
    (void)hipMemsetAsync(d_ws, 0, 16384, stream);
    void* kargs[] = {&a};
    (void)hipLaunchCooperativeKernel((void*)mk_fwd, dim3(grid_blocks), dim3(NTHREADS), kargs, LDS_BYTES, stream);
}
```
